# Optimizing an MI355X kernel written in HIP

```python
import jax, jax.numpy as jnp
from jax import lax
import numpy as np

D_MODEL = 1024
BATCH = 8
SEQ = 2048
DEPTH = 2

D_MIX = D_MODEL
GROUP_W = D_MIX // 4
GRID_W = 64
NA_HEADS = 8
NA_HEAD_DIM = GROUP_W // NA_HEADS
NA_ROWS = 8
NA_COLS = 16
CONV_WIDTH = 31
POOL_WINDOWS = (2, 4, 8, 16)
POOL_GROUPS = len(POOL_WINDOWS)
POOL_GROUP_W = GROUP_W // POOL_GROUPS
SGU_HEADS = 4
SGU_HEAD_DIM = GROUP_W // SGU_HEADS
SGU_CHUNK = 128
D_IN = 8 * GROUP_W + D_MIX
RMS_EPS = 1e-6
LN_EPS = 1e-5

kernel_name = "hybrid_parallel_na_conv_pool_sgu_encoder"


def rmsnorm(x, g):
    xf = x.astype(jnp.float32)
    y = xf * lax.rsqrt(jnp.mean(xf * xf, axis=-1, keepdims=True) + RMS_EPS)
    return (y * g.astype(jnp.float32)).astype(x.dtype)


def layernorm(x, g, b):
    xf = x.astype(jnp.float32)
    mu = jnp.mean(xf, axis=-1, keepdims=True)
    var = jnp.mean(jnp.square(xf - mu), axis=-1, keepdims=True)
    y = (xf - mu) * lax.rsqrt(var + LN_EPS)
    return (y * g.astype(jnp.float32) + b.astype(jnp.float32)).astype(x.dtype)


def neighborhood_attention(q, k, v, rpb):
    B, S, _ = q.shape
    rows = S // GRID_W
    kh = min(NA_ROWS, rows)
    kw = NA_COLS
    H, dh = NA_HEADS, NA_HEAD_DIM
    r = jnp.arange(rows)
    row_start = jnp.clip(r - kh // 2, 0, rows - kh)
    row_idx = row_start[:, None] + jnp.arange(kh)[None, :]
    c = jnp.arange(GRID_W)
    col_start = jnp.clip(c - kw // 2, 0, GRID_W - kw)
    col_ok = (c[None, :] >= col_start[:, None]) & (c[None, :] < col_start[:, None] + kw)
    qg = q.reshape(B, rows, GRID_W, H, dh)
    kband = jnp.take(k.reshape(B, rows, GRID_W, H, dh), row_idx, axis=1)
    vband = jnp.take(v.reshape(B, rows, GRID_W, H, dh), row_idx, axis=1)
    s = jnp.einsum('brqhd,brjkhd->bhrqjk', qg, kband).astype(jnp.float32) * (dh ** -0.5)
    dr = row_idx - r[:, None]
    dc = jnp.clip(c[None, :] - c[:, None], -(kw - 1), kw - 1)
    idx_r = (dr + NA_ROWS - 1)[:, None, :, None]
    idx_c = (dc + NA_COLS - 1)[None, :, None, :]
    bias = rpb[:, idx_r, idx_c].astype(jnp.float32)
    s = jnp.where(col_ok[None, None, None, :, None, :], s + bias[None], -jnp.inf)
    p = jax.nn.softmax(s.reshape(B, H, rows, GRID_W, kh * GRID_W), axis=-1)
    p = p.reshape(B, H, rows, GRID_W, kh, GRID_W).astype(v.dtype)
    out = jnp.einsum('bhrqjk,brjkhd->brqhd', p, vband)
    return out.reshape(B, S, H * dh)


def conformer_conv(a, b, dw_w, dw_b, ln_g, ln_b, pw):
    h = a * jax.nn.sigmoid(b)
    h = lax.conv_general_dilated(h, dw_w[:, None, :], window_strides=(1,),
                                 padding=[(CONV_WIDTH // 2, CONV_WIDTH // 2)],
                                 dimension_numbers=('NWC', 'WIO', 'NWC'),
                                 feature_group_count=h.shape[-1]) + dw_b
    h = jax.nn.silu(layernorm(h, ln_g, ln_b))
    return h @ pw


def multiscale_pool(xc, pool_w, pool_scale):
    B, S, _ = xc.shape
    xg = xc.reshape(B, S, POOL_GROUPS, POOL_GROUP_W).astype(jnp.float32)
    csum = jnp.concatenate([jnp.zeros((B, 1, POOL_GROUPS, POOL_GROUP_W), jnp.float32),
                            jnp.cumsum(xg, axis=1)], axis=1)
    t = jnp.arange(S)[:, None]
    w = jnp.array(POOL_WINDOWS, dtype=jnp.int32)[None, :]
    lo = jnp.clip(t - w // 2, 0, S)
    hi = jnp.clip(t - w // 2 + w, 0, S)
    g_idx = jnp.arange(POOL_GROUPS)[None, :]
    win_sum = csum[:, hi, g_idx] - csum[:, lo, g_idx]
    count = (hi - lo).astype(jnp.float32)[None, :, :, None]
    pooled = (win_sum / count - xg).astype(xc.dtype)
    y = jnp.einsum('bsgc,gcd->bsgd', pooled, pool_w).reshape(B, S, GROUP_W)
    return y * pool_scale


def spatial_gating(u, v, ln_g, ln_b, ws, bs):
    B, S, _ = u.shape
    v = layernorm(v, ln_g, ln_b)
    vc = v.reshape(B, S // SGU_CHUNK, SGU_CHUNK, SGU_HEADS, SGU_HEAD_DIM)
    mixed = jnp.einsum('hpq,bnqhd->bnphd', ws, vc) + bs.T[None, None, :, :, None]
    return u * mixed.reshape(B, S, GROUP_W)


def setup_inputs(seed: int = 0) -> dict:
    key = jax.random.key(seed)
    ks = jax.random.split(key, 20)
    f32 = jnp.float32
    nrm = lambda k, shape, s: jax.random.normal(k, shape, f32) * s
    return {
        "x": nrm(ks[0], (BATCH, SEQ, D_MODEL), 1.0),
        "norm_g": 1.0 + nrm(ks[1], (DEPTH, D_MODEL), 0.02),
        "w_in": nrm(ks[2], (DEPTH, D_MODEL, D_IN), D_MODEL ** -0.5),
        "na_rpb": nrm(ks[3], (DEPTH, NA_HEADS, 2 * NA_ROWS - 1, 2 * NA_COLS - 1), 0.1),
        "conv_dw_w": nrm(ks[4], (DEPTH, CONV_WIDTH, GROUP_W), CONV_WIDTH ** -0.5),
        "conv_dw_b": nrm(ks[5], (DEPTH, GROUP_W), 0.02),
        "conv_ln_g": 1.0 + nrm(ks[6], (DEPTH, GROUP_W), 0.02),
        "conv_ln_b": nrm(ks[7], (DEPTH, GROUP_W), 0.02),
        "conv_pw": nrm(ks[8], (DEPTH, GROUP_W, GROUP_W), GROUP_W ** -0.5),
        "pool_w": nrm(ks[9], (DEPTH, POOL_GROUPS, POOL_GROUP_W, POOL_GROUP_W), POOL_GROUP_W ** -0.5),
        "pool_scale": 1.0 + nrm(ks[10], (DEPTH, GROUP_W), 0.02),
        "sgu_ln_g": 1.0 + nrm(ks[11], (DEPTH, GROUP_W), 0.02),
        "sgu_ln_b": nrm(ks[12], (DEPTH, GROUP_W), 0.02),
        "sgu_w": nrm(ks[13], (DEPTH, SGU_HEADS, SGU_CHUNK, SGU_CHUNK), SGU_CHUNK ** -0.5),
        "sgu_b": 1.0 + nrm(ks[14], (DEPTH, SGU_HEADS, SGU_CHUNK), 0.02),
        "w_out": nrm(ks[15], (DEPTH, D_MIX, D_MODEL), D_MIX ** -0.5),
        "final_g": 1.0 + nrm(ks[16], (D_MODEL,), 0.02),
    }


def reference(x, norm_g, w_in, na_rpb, conv_dw_w, conv_dw_b, conv_ln_g, conv_ln_b, conv_pw,
              pool_w, pool_scale, sgu_ln_g, sgu_ln_b, sgu_w, sgu_b, w_out, final_g):
    split_at = [GROUP_W * i for i in range(1, 9)]
    for l in range(DEPTH):
        h = rmsnorm(x, norm_g[l])
        z = h @ w_in[l]
        qa, ka, va, glu_a, glu_b, pool_in, sgu_u, sgu_v, gates = jnp.split(z, split_at, axis=-1)
        y_a = neighborhood_attention(qa, ka, va, na_rpb[l])
        y_b = conformer_conv(glu_a, glu_b, conv_dw_w[l], conv_dw_b[l], conv_ln_g[l], conv_ln_b[l], conv_pw[l])
        y_c = multiscale_pool(pool_in, pool_w[l], pool_scale[l])
        y_d = spatial_gating(jax.nn.gelu(sgu_u), jax.nn.gelu(sgu_v), sgu_ln_g[l], sgu_ln_b[l], sgu_w[l], sgu_b[l])
        y = jnp.concatenate([y_a, y_b, y_c, y_d], axis=-1) * jax.nn.silu(gates)
        x = x + y @ w_out[l]
    return rmsnorm(x, final_g)
```

```cpp
#include <hip/hip_runtime.h>
#include <hip/hip_cooperative_groups.h>
#include <cstdio>
#include <cstdint>
namespace cg = cooperative_groups;
#ifndef MK_N_LAUNCHES
#define MK_N_LAUNCHES 1
#endif
typedef float f32x2 __attribute__((ext_vector_type(2)));
typedef unsigned u32x2 __attribute__((ext_vector_type(2)));
__device__ __forceinline__ unsigned pk2(float lo, float hi) {
    typedef __bf16 bf2 __attribute__((ext_vector_type(2)));
    bf2 v = __builtin_convertvector((f32x2){lo, hi}, bf2);
    return __builtin_bit_cast(unsigned, v);
}
__device__ __forceinline__ unsigned short bf1(float x) { __bf16 v = (__bf16)x; return __builtin_bit_cast(unsigned short, v); }
__device__ __forceinline__ float bf_lo(unsigned u) { return __uint_as_float(u << 16); }
__device__ __forceinline__ float bf_hi(unsigned u) { return __uint_as_float(u & 0xffff0000u); }
__device__ __forceinline__ float fexp(float x) { return __builtin_amdgcn_exp2f(x * 1.44269504f); }
__device__ __forceinline__ float frcp(float x) { return __builtin_amdgcn_rcpf(x); }
__device__ __forceinline__ float silu_f(float x) { return x * frcp(1.f + fexp(-x)); }
__device__ __forceinline__ float gelu_f(float x) { const float u = 0.7978845608f * (x + 0.044715f * x * x * x); return x * frcp(1.f + fexp(-2.f * u)); }
__device__ __forceinline__ float wave_sum(float v) {
#pragma unroll
    for (int o = 1; o < 64; o <<= 1) v += __shfl_xor(v, o);
    return v;
}
namespace pg8 {
#define PG8_LAS __attribute__((address_space(3)))
typedef unsigned short bf16_t;
typedef short bf16x8 __attribute__((ext_vector_type(8)));
typedef float f32x4 __attribute__((ext_vector_type(4)));
typedef unsigned u32x4 __attribute__((ext_vector_type(4)));
constexpr int BM = 256, BK = 64, HALF = 128, HTB = HALF * BK * 2  , STAGE_BYTES = 8 * HTB, NXCD = 8, WGM = 8;

__host__ __device__ __forceinline__ int lds_byte(int r, int c) { const int st = (r >> 4) * 2 + (c >> 5), rr = r & 15, cc = c & 31, ob = rr * 64 + cc * 2; return st * 1024 + (ob ^ (((ob >> 9) & 1) << 5)); }
__host__ __device__ __forceinline__ void stage_rc(int b, int& R, int& C) { const int st = b / 1024, sb = b % 1024, swz = sb ^ (((sb >> 9) & 1) << 5); R = (st >> 1) * 16 + swz / 64; C = (st & 1) * 32 + (swz % 64) / 2; }
__host__ __device__ __forceinline__ int perm32(int rho) { const int n = rho >> 4, i = rho & 15; return 8 * (i >> 2) + 4 * n + (i & 3); }

struct Unit { int pm, pn; };
struct Gemm { const bf16_t* A; const bf16_t* Bt; int M, N, K; };

struct StaticOrder {
    int nM, nN, nwg, G, c;
    __host__ __device__ void init(int M, int N, int G_, int c_) { nM = M / BM; nN = N / BM; nwg = nM * nN; G = G_; c = c_; }
    __host__ __device__ bool next(int i, Unit& u) const {
        const long L = (long)i * G + c; if (L >= nwg) return false;
        int wgid = (int)L; { const int q = nwg / NXCD, r = nwg % NXCD, xcd = wgid % NXCD, off = wgid / NXCD; wgid = (xcd < r ? xcd * (q + 1) : r * (q + 1) + (xcd - r) * q) + off; }
        const int nig = WGM * nN, gid = wgid / nig, fm = gid * WGM, gsz = (nM - fm) < WGM ? (nM - fm) : WGM;
        u.pm = fm + ((wgid % nig) % gsz); u.pn = (wgid % nig) / gsz; return true;
    }
    __device__ __forceinline__ void a_ready(const Unit&) const {}
    __device__ __forceinline__ void done(const Unit&) const {}
};
struct EpiZ {
    static constexpr bool PERM = true, AFTER_DRAIN = false;
    bf16_t* Z; bf16_t* VT; const float* ssq;
    __device__ __forceinline__ void operator()(const f32x4 (&acc)[2][2][4][2], const Unit& u, int wr, int wc, int fr, int fq) const {
        const int row0 = u.pm * BM + wr * 64 + fr, pn = u.pn, col0 = pn * BM + wc * 32 + 8 * fq;
        const int act = (pn >= 8) ? 2 : (pn >= 6 ? 1 : 0);
#pragma unroll
        for (int ai = 0; ai < 2; ++ai)
#pragma unroll
            for (int m = 0; m < 4; ++m) {
                const int row = row0 + ai * HALF + m * 16;
                const f32x4* sp = (const f32x4*)(ssq + (size_t)row * 16);
                const f32x4 st = (sp[0] + sp[1]) + (sp[2] + sp[3]);
                const float rs = __builtin_amdgcn_rsqf(((st[0] + st[1]) + (st[2] + st[3])) * (1.0f / 1024.0f) + 1e-6f);
#pragma unroll
                for (int bj = 0; bj < 2; ++bj) {
                    f32x4 v0 = acc[ai][bj][m][0] * rs, v1 = acc[ai][bj][m][1] * rs;
                    if (act == 1) {
#pragma unroll
                        for (int e = 0; e < 4; ++e) { v0[e] = gelu_f(v0[e]); v1[e] = gelu_f(v1[e]); }
                    } else if (act == 2) {
#pragma unroll
                        for (int e = 0; e < 4; ++e) { v0[e] = silu_f(v0[e]); v1[e] = silu_f(v1[e]); }
                    }
                    if (pn == 2) {
                        const int b = row >> 11, s = row & 2047, h = 4 * bj + wc;
                        bf16_t* vp = VT + ((size_t)((b * 8 + h) * 32 + 8 * fq)) * 2048 + s;
#pragma unroll
                        for (int e = 0; e < 4; ++e) { vp[(size_t)e * 2048] = bf1(v0[e]); vp[(size_t)(4 + e) * 2048] = bf1(v1[e]); }
                    } else {
                        u32x4 w; w.x = pk2(v0[0], v0[1]); w.y = pk2(v0[2], v0[3]); w.z = pk2(v1[0], v1[1]); w.w = pk2(v1[2], v1[3]);
                        *(u32x4*)(Z + (size_t)row * 3072 + col0 + bj * HALF) = w;
                    }
                }
            }
    }
};
struct EpiX {
    static constexpr bool PERM = false, AFTER_DRAIN = false;
    const float* xin; float* xout; bf16_t* xb; float* ssq; int write_xb;
    __device__ __forceinline__ void operator()(const f32x4 (&acc)[2][2][4][2], const Unit& u, int wr, int wc, int fr, int fq) const {
        const int row0 = u.pm * BM + wr * 64 + fr, col0 = u.pn * BM + wc * 32 + 4 * fq;
#pragma unroll
        for (int ai = 0; ai < 2; ++ai)
#pragma unroll
            for (int m = 0; m < 4; ++m) {
                const int row = row0 + ai * HALF + m * 16; const size_t off = (size_t)row * 1024 + col0;
                float q = 0.f;
#pragma unroll
                for (int bj = 0; bj < 2; ++bj)
#pragma unroll
                    for (int n = 0; n < 2; ++n) {
                        const f32x4 xv = *(const f32x4*)(xin + off + bj * HALF + n * 16);
                        const f32x4 o = xv + acc[ai][bj][m][n];
                        *(f32x4*)(xout + off + bj * HALF + n * 16) = o;
                        q += (o[0] * o[0] + o[1] * o[1]) + (o[2] * o[2] + o[3] * o[3]);
                        if (write_xb) { u32x2 w; w.x = pk2(o[0], o[1]); w.y = pk2(o[2], o[3]); *(u32x2*)(xb + off + bj * HALF + n * 16) = w; }
                    }
                q += __shfl_xor(q, 16); q += __shfl_xor(q, 32);
                if (fq == 0) ssq[(size_t)row * 16 + u.pn * 4 + wc] = q;
            }
    }
};
template <class Epi, class Sched, bool ALIGN_EPI = false, bool SP2 = false>
__device__ __forceinline__ void gemm_phase(PG8_LAS unsigned char* lds, const Gemm g, const Sched& S, const Epi& E) {
    int tid_ = threadIdx.x; asm volatile("" : "+v"(tid_));
    const int tid = tid_, wid = __builtin_amdgcn_readfirstlane(tid >> 6), lane = tid & 63, wr = wid >> 2, wc = wid & 3, fr = lane & 15, fq = lane >> 4;
    const int K = g.K, nt = K / BK;
    unsigned voffA[2], voffB[2];
#pragma unroll
    for (int i = 0; i < 2; ++i) { int R, C; stage_rc(tid * 16 + i * 8192, R, C); const int Rb = Epi::PERM ? ((R & ~31) + perm32(R & 31)) : R;
        voffA[i] = (unsigned)(R * K + C) * 2u; voffB[i] = (unsigned)(Rb * K + C) * 2u; }
    const size_t kstep = (size_t)(BK * 2);
    const size_t hstep = (size_t)HALF * K * 2;
    const size_t tstep = 2 * hstep;
    const unsigned ldsw = (unsigned)wid * 1024u;
    const int aoff = lds_byte(wr * 64 + fr, fq * 8), boff = lds_byte(wc * 32 + fr, fq * 8);
#define PG8_SA(b, h) (((b) * 2 + (h)) * HTB)
#define PG8_SB(b, h) ((4 + (b) * 2 + (h)) * HTB)
#define PG8_STAGE(bufoff, gbase, voff) do { _Pragma("unroll") for (int _i = 0; _i < 2; ++_i) \
        __builtin_amdgcn_global_load_lds((const unsigned*)((const char*)(gbase) + (voff)[_i]), (PG8_LAS unsigned*)(lds + (bufoff) + ldsw + _i * 8192), 16, 0, 0); } while (0)
#define PG8_LDA(dst, b, h) do { _Pragma("unroll") for (int m = 0; m < 4; ++m) _Pragma("unroll") for (int k = 0; k < 2; ++k) dst[m][k] = *(const PG8_LAS bf16x8*)(lds + PG8_SA(b, h) + aoff + m * 2048 + k * 1024); } while (0)
#define PG8_LDB(dst, b, h) do { _Pragma("unroll") for (int n = 0; n < 2; ++n) _Pragma("unroll") for (int k = 0; k < 2; ++k) dst[n][k] = *(const PG8_LAS bf16x8*)(lds + PG8_SB(b, h) + boff + n * 2048 + k * 1024); } while (0)
#define PG8_MMA(ai, bj, At, Bt) do { __builtin_amdgcn_s_setprio(1); _Pragma("unroll") for (int m = 0; m < 4; ++m) _Pragma("unroll") for (int n = 0; n < 2; ++n) _Pragma("unroll") for (int k = 0; k < 2; ++k) \
        acc[ai][bj][m][n] = __builtin_amdgcn_mfma_f32_16x16x32_bf16(Bt[n][k], At[m][k], acc[ai][bj][m][n], 0, 0, 0); __builtin_amdgcn_s_setprio(0); } while (0)
#define PG8_WAIT_V(n) asm volatile("s_waitcnt vmcnt(" #n ")" ::: "memory")
#define PG8_WAIT_L(n) asm volatile("s_waitcnt lgkmcnt(" #n ")" ::: "memory")
#define PG8_BAR __builtin_amdgcn_s_barrier()
#define PG8_SCHED __builtin_amdgcn_sched_barrier(0)
    Unit cur, nxt; int ui = 0;
    if (!S.next(0, cur)) return;
    f32x4 acc[2][2][4][2];
#pragma unroll
    for (int a = 0; a < 2; ++a)
#pragma unroll
        for (int b = 0; b < 2; ++b)
#pragma unroll
            for (int m = 0; m < 4; ++m)
#pragma unroll
                for (int n = 0; n < 2; ++n) acc[a][b][m][n] = (f32x4){0.f, 0.f, 0.f, 0.f};
    bf16x8 At[4][2], B0[2][2], B1[2][2];
    const char* cA = (const char*)g.A + (size_t)cur.pm * tstep; const char* cB = (const char*)g.Bt + (size_t)cur.pn * tstep;
    S.a_ready(cur);
    if constexpr (SP2) {
        PG8_STAGE(PG8_SB(0, 0), cB, voffB); PG8_STAGE(PG8_SB(0, 1), cB + hstep, voffB); PG8_STAGE(PG8_SA(0, 0), cA, voffA); PG8_STAGE(PG8_SA(0, 1), cA + hstep, voffA);
        if (wr == 1) PG8_BAR;
        PG8_WAIT_V(2); PG8_BAR;
        PG8_STAGE(PG8_SB(1, 0), cB + kstep, voffB); PG8_STAGE(PG8_SA(1, 0), cA + kstep, voffA); PG8_STAGE(PG8_SB(1, 1), cB + hstep + kstep, voffB);
        PG8_WAIT_V(6); PG8_BAR;
    } else {
        PG8_STAGE(PG8_SB(0, 0), cB, voffB); PG8_STAGE(PG8_SA(0, 0), cA, voffA); PG8_STAGE(PG8_SB(0, 1), cB + hstep, voffB); PG8_STAGE(PG8_SA(0, 1), cA + hstep, voffA);
        if (wr == 1) PG8_BAR;
        PG8_WAIT_V(4); PG8_BAR;
        PG8_STAGE(PG8_SB(1, 0), cB + kstep, voffB); PG8_STAGE(PG8_SA(1, 0), cA + kstep, voffA); PG8_STAGE(PG8_SB(1, 1), cB + hstep + kstep, voffB);
        PG8_WAIT_V(6); PG8_BAR;
    }
    for (;;) {
        const bool has_next = S.next(ui + 1, nxt);
        const char* nA = has_next ? (const char*)g.A + (size_t)nxt.pm * tstep : cA; const char* nB = has_next ? (const char*)g.Bt + (size_t)nxt.pn * tstep : cB;
        for (int t = 0; t < nt; t += 2) {
            const bool last = (t == nt - 2);
            const char* a1 = cA + (size_t)(t + 1) * kstep;
            const char* a2 = last ? nA : cA + (size_t)(t + 2) * kstep; const char* b2 = last ? nB : cB + (size_t)(t + 2) * kstep;
            const char* a3 = a2 + kstep; const char* b3 = b2 + kstep;
            if (last && has_next) S.a_ready(nxt);
            if constexpr (SP2) {
            PG8_LDB(B0, 0, 0); PG8_LDB(B1, 0, 1); PG8_SCHED; PG8_LDA(At, 0, 0); PG8_STAGE(PG8_SA(1, 1), a1 + hstep, voffA);
            PG8_WAIT_V(8); PG8_WAIT_L(0); PG8_BAR; PG8_MMA(0, 0, At, B0); PG8_MMA(0, 1, At, B1); PG8_BAR; PG8_SCHED;
            PG8_LDA(At, 0, 1); PG8_STAGE(PG8_SB(0, 0), b2, voffB); PG8_STAGE(PG8_SB(0, 1), b2 + hstep, voffB); PG8_STAGE(PG8_SA(0, 0), a2, voffA);
            PG8_WAIT_V(8); PG8_WAIT_L(0); PG8_BAR; PG8_MMA(1, 0, At, B0); PG8_MMA(1, 1, At, B1); PG8_BAR; PG8_SCHED;
            PG8_LDB(B0, 1, 0); PG8_LDB(B1, 1, 1); PG8_SCHED; PG8_LDA(At, 1, 0); PG8_STAGE(PG8_SA(0, 1), a2 + hstep, voffA);
            PG8_WAIT_V(8); PG8_WAIT_L(0); PG8_BAR; PG8_MMA(0, 0, At, B0); PG8_MMA(0, 1, At, B1); PG8_BAR; PG8_SCHED;
            PG8_LDA(At, 1, 1); PG8_STAGE(PG8_SB(1, 0), b3, voffB); PG8_STAGE(PG8_SB(1, 1), b3 + hstep, voffB); PG8_STAGE(PG8_SA(1, 0), a3, voffA);
            PG8_WAIT_V(8); PG8_WAIT_L(0); PG8_BAR; PG8_MMA(1, 0, At, B0); PG8_MMA(1, 1, At, B1); PG8_BAR; PG8_SCHED;
            } else {
            PG8_LDB(B0, 0, 0); PG8_SCHED; PG8_LDA(At, 0, 0); PG8_STAGE(PG8_SA(1, 1), a1 + hstep, voffA);
            PG8_WAIT_L(8); PG8_BAR; PG8_WAIT_L(0); PG8_MMA(0, 0, At, B0); PG8_BAR; PG8_SCHED;
            PG8_LDB(B1, 0, 1); PG8_STAGE(PG8_SB(0, 0), b2, voffB);
            PG8_BAR; PG8_WAIT_L(0); PG8_MMA(0, 1, At, B1); PG8_BAR;
            PG8_LDA(At, 0, 1); PG8_STAGE(PG8_SA(0, 0), a2, voffA);
            PG8_BAR; PG8_WAIT_L(0); PG8_MMA(1, 0, At, B0); PG8_BAR; PG8_SCHED;
            PG8_STAGE(PG8_SB(0, 1), b2 + hstep, voffB);
            PG8_WAIT_V(6); PG8_BAR; PG8_MMA(1, 1, At, B1); PG8_BAR;
            PG8_LDB(B0, 1, 0); PG8_SCHED; PG8_LDA(At, 1, 0); PG8_STAGE(PG8_SA(0, 1), a2 + hstep, voffA);
            PG8_WAIT_L(8); PG8_BAR; PG8_WAIT_L(0); PG8_MMA(0, 0, At, B0); PG8_BAR; PG8_SCHED;
            PG8_LDB(B1, 1, 1); PG8_STAGE(PG8_SB(1, 0), b3, voffB);
            PG8_BAR; PG8_WAIT_L(0); PG8_MMA(0, 1, At, B1); PG8_BAR;
            PG8_LDA(At, 1, 1); PG8_STAGE(PG8_SA(1, 0), a3, voffA);
            PG8_BAR; PG8_WAIT_L(0); PG8_MMA(1, 0, At, B0); PG8_BAR; PG8_SCHED;
            PG8_STAGE(PG8_SB(1, 1), b3 + hstep, voffB);
            PG8_WAIT_V(6); PG8_BAR; PG8_MMA(1, 1, At, B1); PG8_BAR;
            }
        }
        if constexpr (ALIGN_EPI) { if (wr == 0) PG8_BAR; }
        if constexpr (!Epi::AFTER_DRAIN) { E(acc, cur, wr, wc, fr, fq); S.done(cur); }
        if (!has_next) break;
#pragma unroll
        for (int a = 0; a < 2; ++a)
#pragma unroll
            for (int b = 0; b < 2; ++b)
#pragma unroll
                for (int m = 0; m < 4; ++m)
#pragma unroll
                    for (int n = 0; n < 2; ++n) acc[a][b][m][n] = (f32x4){0.f, 0.f, 0.f, 0.f};
        cur = nxt; cA = nA; cB = nB; ++ui;
        if constexpr (ALIGN_EPI) { if (wr == 1) PG8_BAR; }
    }
    PG8_WAIT_V(0);
    if constexpr (!ALIGN_EPI) { if (wr == 0) PG8_BAR; }
    PG8_BAR;
    if constexpr (Epi::AFTER_DRAIN) { E.fused(acc, cur, wr, wc, fr, fq, lds, wid, lane); S.done(cur); }
#undef PG8_SA
#undef PG8_SB
#undef PG8_STAGE
#undef PG8_LDA
#undef PG8_LDB
#undef PG8_MMA
#undef PG8_WAIT_V
#undef PG8_WAIT_L
#undef PG8_BAR
#undef PG8_SCHED
}
}

#define LAS __attribute__((address_space(3)))
typedef unsigned short bf16_t;
typedef short bf16x8 __attribute__((ext_vector_type(8)));
typedef float f32x4 __attribute__((ext_vector_type(4)));
typedef unsigned u32x4 __attribute__((ext_vector_type(4)));
constexpr int NWAVES = 8, NT = NWAVES * 64;
constexpr int M = 16384, DM = 1024, DIN = 3072, SEQ = 2048, DEPTH = 2;
constexpr size_t MiB = 1u << 20;
constexpr size_t WS_WIN = 2 * MiB, WS_WOUT = 14 * MiB, WS_PW = 18 * MiB, WS_POOL = 18 * MiB + 256 * 1024, WS_SGW = 18 * MiB + 512 * 1024;
constexpr size_t WS_SSQ = 19 * MiB, WS_XB = 20 * MiB, WS_Y = 52 * MiB, WS_VT = 84 * MiB, WS_Z = 92 * MiB, WS_END = 188 * MiB;
constexpr int LDS_BYTES = 147456, RPB_OFF = 131072, BAR_LDS_OFF = 146432;
constexpr int L_R0 = 0, L_R1 = 49920, L_R2 = 91904, L_STAT = 129024, ROWB = 528  , VNT_ROWB = 272;
#define MFMA16(a, b, c) __builtin_amdgcn_mfma_f32_16x16x32_bf16((a), (b), (c), 0, 0, 0)
#define LDS_WAIT() asm volatile("s_waitcnt lgkmcnt(0)" ::: "memory")
#define LBAR() do { asm volatile("s_waitcnt lgkmcnt(0)" ::: "memory"); __builtin_amdgcn_s_barrier(); asm volatile("" ::: "memory"); } while (0)

#ifndef G2REP
#define G2REP 1
#endif
#ifndef G1REP
#define G1REP 1
#endif
#ifndef PROREP
#define PROREP 1
#endif
#ifndef NA_PROBE_VAR
#define NA_PROBE_VAR 0
#endif
#ifndef REP_NA
#define REP_NA 1
#endif
#ifndef REP_CONV
#define REP_CONV 1
#endif
#ifndef REP_POOL
#define REP_POOL 1
#endif
#ifndef REP_SGU
#define REP_SGU 1
#endif
#ifndef NA_UNROLL
#define NA_UNROLL 4
#endif
#ifndef MIXREP
#define MIXREP 1
#endif
#ifndef MIXMASK
#define MIXMASK 15
#endif
#ifndef PHMASK
#define PHMASK 31
#endif
struct Args { const float* in[17]; float* out; unsigned char* ws; int ph_lo, ph_hi; };

#define XB_TMO      128
#define XB_XCNT(j)  (256  + 64 * (j))
#define XB_XSUB(j)  (1280 + 64 * (j))
#define XB_XGEN(j)  (2304 + 64 * (j))
#define XB_TOP      3328
#define XB_TOPGEN   3392
#define XCD_BAR_WORDS 3456
#define XB_SPIN_CAP (1u << 18)

__device__ __forceinline__ unsigned xb_ld(unsigned* p)              { return __hip_atomic_load(p, __ATOMIC_RELAXED, __HIP_MEMORY_SCOPE_AGENT); }
__device__ __forceinline__ unsigned xb_add(unsigned* p, unsigned v) { return __hip_atomic_fetch_add(p, v, __ATOMIC_RELAXED, __HIP_MEMORY_SCOPE_AGENT); }
__device__ __forceinline__ unsigned xb_xcc_id() { return (unsigned)__builtin_amdgcn_s_getreg((3 << 11) | 20) & 0xFu; }
#define XB_SPIN(cond, bar) do { unsigned _sp = 0; while (cond) { __builtin_amdgcn_s_sleep(1); \
    if ((++_sp & 255u) == 0u) { if (xb_ld(&(bar)[XB_TMO])) break; if (_sp > XB_SPIN_CAP) { atomicAdd(&(bar)[XB_TMO], 1u); break; } } } } while (0)

struct XcdBarrier {
    unsigned* bar; unsigned x;
    volatile LAS unsigned* st;
};

__device__ __forceinline__ XcdBarrier xcd_barrier_post(unsigned* bar, volatile LAS unsigned* st) {
    XcdBarrier b; b.bar = bar; b.x = xb_xcc_id(); b.st = st;
    if (threadIdx.x == 0) (void)xb_add(&bar[XB_XCNT(b.x)], 1u);
    return b;
}
__device__ __forceinline__ void xcd_barrier_complete(unsigned* bar, unsigned x, unsigned& nloc, unsigned& nx) {
    const unsigned G = gridDim.x * gridDim.y * gridDim.z;
    unsigned sum, cnt, mine, sp = 0u;
    for (;;) {
        sum = 0u; cnt = 0u; mine = 0u;
#pragma unroll
        for (unsigned j = 0; j < 16; ++j) { const unsigned c = xb_ld(&bar[XB_XCNT(j)]); sum += c; cnt += (c > 0u) ? 1u : 0u; mine = (j == x) ? c : mine; }
        if (sum == G) break;
        __builtin_amdgcn_s_sleep(1);
        if ((++sp & 255u) == 0u) { if (xb_ld(&bar[XB_TMO])) break; if (sp > XB_SPIN_CAP) { atomicAdd(&bar[XB_TMO], 1u); break; } }
    }
    nloc = mine > 0u ? mine : 1u; nx = cnt > 0u ? cnt : 1u;
}

__device__ __forceinline__ void xcd_barrier(const XcdBarrier& b) {
    asm volatile("s_waitcnt vmcnt(0)" ::: "memory");
    __syncthreads();
    if (threadIdx.x == 0) {
        unsigned* bar = b.bar;
        __builtin_amdgcn_s_waitcnt(0);
        unsigned nloc = b.st[0], nx = b.st[1];
        if (nloc == 0u) { xcd_barrier_complete(bar, b.x, nloc, nx); b.st[0] = nloc; b.st[1] = nx; }
        const unsigned old = xb_add(&bar[XB_XSUB(b.x)], 1u);
        const unsigned gen = old / nloc;
        if (old + 1u == (gen + 1u) * nloc) {
            __builtin_amdgcn_fence(__ATOMIC_RELEASE, "agent");
            asm volatile("s_waitcnt vmcnt(0)" ::: "memory");
            const unsigned og = xb_add(&bar[XB_TOP], 1u);
            const unsigned tg = og / nx;
            if (og + 1u == (tg + 1u) * nx) xb_add(&bar[XB_TOPGEN], 1u);
            else XB_SPIN(xb_ld(&bar[XB_TOPGEN]) == tg, bar);
            __builtin_amdgcn_fence(__ATOMIC_ACQUIRE, "agent");
            xb_add(&bar[XB_XGEN(b.x)], 1u);
            asm volatile("s_waitcnt vmcnt(0)" ::: "memory");
        } else {
            XB_SPIN(xb_ld(&bar[XB_XGEN(b.x)]) == gen, bar);
            __builtin_amdgcn_fence(__ATOMIC_ACQUIRE, "agent");
            asm volatile("s_waitcnt vmcnt(0)" ::: "memory");
        }
    }
    __syncthreads();
}

__device__ __forceinline__ void transpose_item(const float* W, int K, int N, bf16_t* WT, LAS float* scr, int item, int lane, const float* ks, const float* ns, int qcols) {
    const int nblk = N / 32, kb = item / nblk, nb = item % nblk, k0 = 64 * kb, n0 = 32 * nb, n = n0 + (lane & 31);
    float nsv = ns ? ns[n] : 1.f; if (n < qcols) nsv *= 0.17677669529663687f;
#pragma unroll 8
    for (int i = 0; i < 32; ++i) { const int kk = 2 * i + (lane >> 5); const float kv = ks ? ks[k0 + kk] : 1.f; scr[kk * 33 + (lane & 31)] = W[(size_t)(k0 + kk) * N + n] * (kv * nsv); }
    LDS_WAIT(); asm volatile("" ::: "memory");
    const int c = lane & 7;
#pragma unroll
    for (int j = 0; j < 4; ++j) { const int nn = (lane >> 3) + 8 * j; const LAS float* s = scr + (8 * c) * 33 + nn;
        u32x4 o; o.x = pk2(s[0 * 33], s[1 * 33]); o.y = pk2(s[2 * 33], s[3 * 33]); o.z = pk2(s[4 * 33], s[5 * 33]); o.w = pk2(s[6 * 33], s[7 * 33]);
        *(u32x4*)(WT + (size_t)(n0 + nn) * K + k0 + 8 * c) = o; }
    LDS_WAIT(); asm volatile("" ::: "memory");
}
__device__ __forceinline__ void prologue(LAS unsigned char* lds, const Args& a) {
    const int tid = threadIdx.x, lane = tid & 63, wave = __builtin_amdgcn_readfirstlane(tid >> 6);
    LAS float* scr = (LAS float*)(lds + wave * 16384);
    const int gw = blockIdx.x * NWAVES + wave, NGW = gridDim.x * NWAVES;
    unsigned char* ws = a.ws;
    constexpr int I_IN = 16 * 96, I_OUT = 16 * 32, I_PW = 4 * 8, I_PL = 2, PER_L = I_IN + I_OUT + I_PW + 4 * I_PL;
    for (int it = gw; it < DEPTH * PER_L; it += NGW) {
        const int l = it / PER_L; int r = it % PER_L;
        if (r < I_IN) { transpose_item(a.in[2] + (size_t)l * DM * DIN, DM, DIN, (bf16_t*)(ws + WS_WIN) + (size_t)l * DIN * DM, scr, r, lane, a.in[1] + l * DM, nullptr, 256); continue; } r -= I_IN;
        if (r < I_OUT) { transpose_item(a.in[15] + (size_t)l * DM * DM, DM, DM, (bf16_t*)(ws + WS_WOUT) + (size_t)l * DM * DM, scr, r, lane, nullptr, nullptr, 0); continue; } r -= I_OUT;
        if (r < I_PW) { transpose_item(a.in[8] + (size_t)l * 65536, 256, 256, (bf16_t*)(ws + WS_PW) + (size_t)l * 65536, scr, r, lane, nullptr, nullptr, 0); continue; } r -= I_PW;
        { const int g = r / I_PL, i = r % I_PL;
          transpose_item(a.in[9] + (size_t)(l * 4 + g) * 4096, 64, 64, (bf16_t*)(ws + WS_POOL) + (size_t)(l * 4 + g) * 4096, scr, i, lane, nullptr, a.in[10] + l * 256 + g * 64, 0); }
    }
    { const float* src = a.in[13]; bf16_t* dst = (bf16_t*)(ws + WS_SGW);
      for (int i = (blockIdx.x * NT + tid) * 4; i < DEPTH * 65536; i += gridDim.x * NT * 4) { const f32x4 v = *(const f32x4*)(src + i); u32x2 w; w.x = pk2(v[0], v[1]); w.y = pk2(v[2], v[3]); *(u32x2*)(dst + i) = w; } }
    { const float* x = a.in[0]; bf16_t* xb = (bf16_t*)(ws + WS_XB); float* ssq = (float*)(ws + WS_SSQ);
      for (int m = gw; m < M; m += NGW) {
          const f32x4* xr = (const f32x4*)(x + (size_t)m * DM) + lane; f32x4 v[4]; float s = 0.f;
#pragma unroll
          for (int j = 0; j < 4; ++j) { v[j] = xr[64 * j]; s += (v[j][0] * v[j][0] + v[j][1] * v[j][1]) + (v[j][2] * v[j][2] + v[j][3] * v[j][3]); }
          s = wave_sum(s);
          u32x2* o = (u32x2*)(xb + (size_t)m * DM) + lane;
#pragma unroll
          for (int j = 0; j < 4; ++j) { u32x2 w; w.x = pk2(v[j][0], v[j][1]); w.y = pk2(v[j][2], v[j][3]); o[64 * j] = w; }
          if (lane < 16) ssq[(size_t)m * 16 + lane] = (lane == 0) ? s : 0.f;
      } }
}

struct MixW { const float *rpb, *dw_w, *dw_b, *cln_g, *cln_b, *sln_g, *sln_b, *sgu_b; const bf16_t *PWT, *POOLT, *SGW; };

#define LANE_VARS int tid = tid0; asm volatile("" : "+v"(tid)); const int lane = tid & 63, fr = lane & 15, fq = lane >> 4, c0 = half * 128 + 2 * lane; (void)fr; (void)fq; (void)c0;
template <int nav>
__device__ __forceinline__ void na_stage(const bf16_t* Z, const bf16_t* Zb, const bf16_t* VT, bf16_t* Y, LAS float* rpbL, int b, int r, int tok0, int wid, int tid0, int half) {
    const f32x4 zero4 = {0.f, 0.f, 0.f, 0.f};
    {
            LANE_VARS
            const int h = wid, rs = min(max(r - 4, 0), 24);
            const bf16_t* VTh = VT + (size_t)(b * 8 + h) * 32 * SEQ;
            const int kperm = (fr >> 2) * 8 + (fr & 3);
#define NA_CW0(qb) ((qb) == 0 ? 0 : ((qb) == 1 ? 8 : ((qb) == 2 ? 24 : 32)))
            const int klane = kperm * DIN + fq * 8, qlane = fr * DIN + fq * 8, vlane = fr * SEQ + fq * 8, glane = fr * DIN + 4 * fq;
            const bf16_t* Kh = Zb + (size_t)rs * 64 * DIN + 256 + h * 32;
#define NA_KLOAD(dst, qb) do { _Pragma("unroll") for (int j = 0; j < 8; ++j) _Pragma("unroll") for (int t = 0; t < 2; ++t) \
                dst[j][t] = *(const bf16x8*)((Kh + (size_t)(j * 64 + NA_CW0(qb) + t * 4) * DIN) + klane); } while (0)
#define NA_QLOAD(qb) (*(const bf16x8*)((Zb + (size_t)(r * 64 + 16 * (qb)) * DIN + h * 32) + qlane))
            bf16x8 qcur = NA_QLOAD(0), qnxt = qcur;
            bf16x8 kf[8][2];
            if (nav != 1) NA_KLOAD(kf, 0); else { _Pragma("unroll") for (int j = 0; j < 8; ++j) { kf[j][0] = qcur; kf[j][1] = qcur; } }
            __builtin_amdgcn_sched_barrier(0);
#pragma unroll
            for (int qb = 0; qb < 4; ++qb) {
                const int c = 16 * qb + fr, cw0 = NA_CW0(qb), cs = min(max(c - 8, 0), 48);
                f32x4 S[8][2];
#pragma unroll
                for (int j = 0; j < 8; ++j)
#pragma unroll
                    for (int t = 0; t < 2; ++t) S[j][t] = MFMA16(kf[j][t], qcur, zero4);
                __builtin_amdgcn_sched_barrier(0);
                bf16x8 vf[8][2];
#pragma unroll
                for (int j = 0; j < 8; ++j)
#pragma unroll
                    for (int dt = 0; dt < 2; ++dt) { if (nav != 1) vf[j][dt] = *(const bf16x8*)((VTh + (size_t)(dt * 16) * SEQ + (rs + j) * 64 + cw0) + vlane); else vf[j][dt] = qcur; }
                u32x2 gv[2];
#pragma unroll
                for (int dt = 0; dt < 2; ++dt) gv[dt] = *(const u32x2*)((Z + (size_t)(tok0 + 16 * qb) * DIN + 2048 + h * 32 + dt * 16) + glane);
                __builtin_amdgcn_sched_barrier(0);
                float mx = -INFINITY;
                if (nav != 2)
#pragma unroll
                for (int j = 0; j < 8; ++j) {
                    const LAS float* rp = rpbL + h * 465 + (rs + j - r + 7) * 31 + 15;
#pragma unroll
                    for (int t = 0; t < 2; ++t)
#pragma unroll
                        for (int e = 0; e < 4; ++e) {
                            const int kc = cw0 + fq * 8 + t * 4 + e; const bool valid = (kc >= cs) && (kc < cs + 16);
                            const int dc = min(max(kc - c, -15), 15);
                            float sv = S[j][t][e] + rp[dc]; sv = valid ? sv : -INFINITY; S[j][t][e] = sv; mx = fmaxf(mx, sv);
                        }
                    if (j & 1) __builtin_amdgcn_sched_barrier(0);
                }
                mx = fmaxf(mx, __shfl_xor(mx, 16)); mx = fmaxf(mx, __shfl_xor(mx, 32));
                float sum = (nav == 2) ? 1.f : 0.f;
                if (nav != 2)
#pragma unroll
                for (int j = 0; j < 8; ++j)
#pragma unroll
                    for (int t = 0; t < 2; ++t)
#pragma unroll
                        for (int e = 0; e < 4; ++e) { const float p = __builtin_amdgcn_exp2f((S[j][t][e] - mx) * 1.44269504f); S[j][t][e] = p; sum += p; }
                sum += __shfl_xor(sum, 16); sum += __shfl_xor(sum, 32);
                const float inv = frcp(sum);
                f32x4 O[2] = {zero4, zero4};
                bf16x8 pf[8];
#pragma unroll
                for (int j = 0; j < 8; ++j) {
                    u32x4 pw; pw.x = pk2(S[j][0][0], S[j][0][1]); pw.y = pk2(S[j][0][2], S[j][0][3]); pw.z = pk2(S[j][1][0], S[j][1][1]); pw.w = pk2(S[j][1][2], S[j][1][3]);
                    pf[j] = __builtin_bit_cast(bf16x8, pw);
                }
                __builtin_amdgcn_sched_barrier(0);
                if (qb < 3) { qnxt = NA_QLOAD(qb + 1); if (nav != 1) NA_KLOAD(kf, qb + 1); }
                __builtin_amdgcn_sched_barrier(0);
#pragma unroll
                for (int j = 0; j < 8; ++j)
#pragma unroll
                    for (int dt = 0; dt < 2; ++dt) O[dt] = MFMA16(vf[j][dt], pf[j], O[dt]);
#pragma unroll
                for (int dt = 0; dt < 2; ++dt) {
                    const int ch = h * 32 + dt * 16 + 4 * fq;
                    u32x2 w; w.x = pk2(O[dt][0] * inv * bf_lo(gv[dt].x), O[dt][1] * inv * bf_hi(gv[dt].x)); w.y = pk2(O[dt][2] * inv * bf_lo(gv[dt].y), O[dt][3] * inv * bf_hi(gv[dt].y));
                    *(u32x2*)(Y + (size_t)(tok0 + c) * DM + ch) = w;
                }
                qcur = qnxt;
                __builtin_amdgcn_sched_barrier(0);
            }
            }
}

__device__ __forceinline__ void mixer_phase(LAS unsigned char* lds, const bf16_t* Z, const bf16_t* VT, bf16_t* Y, const MixW& W) {
    const int tid0 = threadIdx.x, wid = __builtin_amdgcn_readfirstlane(tid0 >> 6);
    LAS float* rpbL = (LAS float*)(lds + RPB_OFF);
    for (int i = tid0; i < 8 * 465; i += NT) rpbL[i] = W.rpb[i];
    const f32x4 zero4 = {0.f, 0.f, 0.f, 0.f};
    const int tq = wid >> 1, half = wid & 1;
    for (int item = blockIdx.x; item < 256; item += gridDim.x) {
        LBAR();
        const int b = item & 7, r = item >> 3, tok0 = b * SEQ + r * 64;
        const bf16_t* Zb = Z + (size_t)b * SEQ * DIN;
        if (MIXMASK & 1) {
            for (int rep_ = 0; rep_ + 1 < REP_NA; ++rep_) { na_stage<NA_PROBE_VAR>(Z, Zb, VT, Y, rpbL, b, r, tok0, wid, tid0, half); LBAR(); }
            na_stage<0>(Z, Zb, VT, Y, rpbL, b, r, tok0, wid, tid0, half);
        }
        if (MIXMASK & 2) for (int rep_ = 0; rep_ < REP_CONV; ++rep_) {
            if (rep_) LBAR();
            LANE_VARS
            LAS unsigned char* Hb = lds + L_R0; LAS unsigned char* Hn = lds + L_R0; LAS unsigned char* Cf = lds + L_R1; LAS f32x2* stat = (LAS f32x2*)(lds + L_STAT);
            {
                u32x4 av[6], bv[6];
#pragma unroll
                for (int k = 0; k < 6; ++k) {
                    const int task = tid + k * NT, tt = task >> 5, ch = task & 31, s = r * 64 - 15 + tt;
                    av[k] = (u32x4){0u, 0u, 0u, 0u}; bv[k] = av[k];
                    if (task < 94 * 32 && s >= 0 && s < SEQ) { av[k] = *(const u32x4*)(Zb + (size_t)s * DIN + 768 + ch * 8); bv[k] = *(const u32x4*)(Zb + (size_t)s * DIN + 1024 + ch * 8); }
                }
                __builtin_amdgcn_sched_barrier(0);
#pragma unroll
                for (int k = 0; k < 6; ++k) {
                    const int task = tid + k * NT, tt = task >> 5, ch = task & 31;
                    u32x4 o;
#pragma unroll
                    for (int e = 0; e < 4; ++e) { const float a0 = bf_lo(av[k][e]), a1 = bf_hi(av[k][e]), b0 = bf_lo(bv[k][e]), b1 = bf_hi(bv[k][e]);
                        o[e] = pk2(a0 * frcp(1.f + fexp(-b0)), a1 * frcp(1.f + fexp(-b1))); }
                    if (task < 94 * 32) *(LAS u32x4*)(Hb + tt * ROWB + ch * 16) = o;
                }
            }
            f32x2 wv[31];
#pragma unroll
            for (int j = 0; j < 31; ++j) wv[j] = *(const f32x2*)(W.dw_w + j * 256 + c0);
            const f32x2 bias = *(const f32x2*)(W.dw_b + c0);
            __builtin_amdgcn_sched_barrier(0);
            LBAR();
#pragma unroll 1
            for (int p = 0; p < 2; ++p) {
                const int tb = tq * 16 + p * 8;
                float a0[8], a1[8];
#pragma unroll
                for (int t = 0; t < 8; ++t) { a0[t] = bias[0]; a1[t] = bias[1]; }
#pragma unroll
                for (int jg = 0; jg < 40; jg += 8) {
                    unsigned hv[8];
#pragma unroll
                    for (int i = 0; i < 8; ++i) if (jg + i < 38) hv[i] = *(const LAS unsigned*)(Hb + (tb + jg + i) * ROWB + c0 * 2);
#pragma unroll
                    for (int i = 0; i < 8; ++i) if (jg + i < 38) {
                        const int jj = jg + i; const float v0 = bf_lo(hv[i]), v1 = bf_hi(hv[i]);
#pragma unroll
                        for (int t = 0; t < 8; ++t) { const int tap = jj - t; if (tap >= 0 && tap <= 30) { a0[t] += v0 * wv[tap][0]; a1[t] += v1 * wv[tap][1]; } }
                    }
                    __builtin_amdgcn_sched_barrier(0);
                }
#pragma unroll
                for (int t = 0; t < 8; ++t) {
                    const float s1 = wave_sum(a0[t] + a1[t]), s2 = wave_sum(a0[t] * a0[t] + a1[t] * a1[t]);
                    if (lane == 0) stat[(tb + t) * 2 + half] = (f32x2){s1, s2};
                    *(LAS f32x2*)(Cf + ((tb + t) * 256 + c0) * 4) = (f32x2){a0[t], a1[t]};
                }
            }
            const f32x2 lg = *(const f32x2*)(W.cln_g + c0), lb = *(const f32x2*)(W.cln_b + c0);
            bf16x8 afw[8][2];
#pragma unroll
            for (int ks = 0; ks < 8; ++ks)
#pragma unroll
                for (int nt = 0; nt < 2; ++nt) afw[ks][nt] = *(const bf16x8*)(W.PWT + (size_t)(wid * 32 + nt * 16 + fr) * 256 + ks * 32 + fq * 8);
            u32x2 gvv[2][4];
#pragma unroll
            for (int nt = 0; nt < 2; ++nt)
#pragma unroll
                for (int tt = 0; tt < 4; ++tt) gvv[nt][tt] = *(const u32x2*)(Z + (size_t)(tok0 + tt * 16 + fr) * DIN + 2048 + 256 + wid * 32 + nt * 16 + 4 * fq);
            __builtin_amdgcn_sched_barrier(0);
            LBAR();
#pragma unroll 4
            for (int t = 0; t < 16; ++t) {
                const f32x2 p = stat[(tq * 16 + t) * 2], q = stat[(tq * 16 + t) * 2 + 1];
                const f32x2 cv = *(const LAS f32x2*)(Cf + ((tq * 16 + t) * 256 + c0) * 4);
                const float mean = (p[0] + q[0]) * (1.f / 256.f), var = (p[1] + q[1]) * (1.f / 256.f) - mean * mean, rstd = __builtin_amdgcn_rsqf(var + 1e-5f);
                const float y0 = (cv[0] - mean) * rstd * lg[0] + lb[0], y1 = (cv[1] - mean) * rstd * lg[1] + lb[1];
                *(LAS unsigned*)(Hn + (tq * 16 + t) * ROWB + c0 * 2) = pk2(silu_f(y0), silu_f(y1));
            }
            LBAR();
            f32x4 acc[2][4];
#pragma unroll
            for (int nt = 0; nt < 2; ++nt)
#pragma unroll
                for (int tt = 0; tt < 4; ++tt) acc[nt][tt] = zero4;
#pragma unroll
            for (int ks = 0; ks < 8; ++ks) {
                bf16x8 bfr[4];
#pragma unroll
                for (int tt = 0; tt < 4; ++tt) bfr[tt] = *(const LAS bf16x8*)(Hn + (tt * 16 + fr) * ROWB + (ks * 32 + fq * 8) * 2);
#pragma unroll
                for (int nt = 0; nt < 2; ++nt)
#pragma unroll
                    for (int tt = 0; tt < 4; ++tt) acc[nt][tt] = MFMA16(afw[ks][nt], bfr[tt], acc[nt][tt]);
            }
#pragma unroll
            for (int nt = 0; nt < 2; ++nt)
#pragma unroll
                for (int tt = 0; tt < 4; ++tt) {
                    const int ch = wid * 32 + nt * 16 + 4 * fq; const size_t tok = (size_t)(tok0 + tt * 16 + fr);
                    const u32x2 gv = gvv[nt][tt];
                    u32x2 w; w.x = pk2(acc[nt][tt][0] * bf_lo(gv.x), acc[nt][tt][1] * bf_hi(gv.x)); w.y = pk2(acc[nt][tt][2] * bf_lo(gv.y), acc[nt][tt][3] * bf_hi(gv.y));
                    *(u32x2*)(Y + tok * DM + 256 + ch) = w;
                }
        }
        if (MIXMASK & 4) for (int rep_ = 0; rep_ < REP_POOL; ++rep_) {
            if (rep_) LBAR();
            LANE_VARS
            LAS unsigned char* Pin = lds + L_R1; LAS unsigned char* Pn = lds + L_R2;
            {
                u32x4 pv[5];
#pragma unroll
                for (int k = 0; k < 5; ++k) {
                    const int task = tid + k * NT, tt = task >> 5, ch = task & 31, s = r * 64 - 8 + tt;
                    pv[k] = (u32x4){0u, 0u, 0u, 0u};
                    if (task < 79 * 32 && s >= 0 && s < SEQ) pv[k] = *(const u32x4*)(Zb + (size_t)s * DIN + 1280 + ch * 8);
                }
                __builtin_amdgcn_sched_barrier(0);
#pragma unroll
                for (int k = 0; k < 5; ++k) { const int task = tid + k * NT, tt = task >> 5, ch = task & 31; if (task < 79 * 32) *(LAS u32x4*)(Pin + tt * ROWB + ch * 16) = pv[k]; }
            }
            bf16x8 afp[2][2];
#pragma unroll
            for (int ks = 0; ks < 2; ++ks)
#pragma unroll
                for (int nt = 0; nt < 2; ++nt) afp[ks][nt] = *(const bf16x8*)(W.POOLT + (size_t)(wid * 32 + nt * 16 + fr) * 64 + ks * 32 + fq * 8);
            u32x2 gvp[2][4];
#pragma unroll
            for (int nt = 0; nt < 2; ++nt)
#pragma unroll
                for (int tt = 0; tt < 4; ++tt) gvp[nt][tt] = *(const u32x2*)(Z + (size_t)(tok0 + tt * 16 + fr) * DIN + 2048 + 512 + wid * 32 + nt * 16 + 4 * fq);
            __builtin_amdgcn_sched_barrier(0);
            LBAR();
            {
                const int g = half * 2 + (lane >> 5), w = 2 << g, hw = w >> 1;
#pragma unroll 4
                for (int t = 0; t < 16; ++t) {
                    const int ta = tq * 16 + t, s = r * 64 + ta;
                    const int lo = max(s - hw, 0), hi = min(s - hw + w, SEQ);
                    float p0 = 0.f, p1 = 0.f;
#pragma unroll
                    for (int i = 0; i < 16; ++i) if (i < w) { const unsigned v = *(const LAS unsigned*)(Pin + (ta + 8 - hw + i) * ROWB + c0 * 2); p0 += bf_lo(v); p1 += bf_hi(v); }
                    const unsigned xc = *(const LAS unsigned*)(Pin + (ta + 8) * ROWB + c0 * 2);
                    const float ic = 1.f / (float)(hi - lo);
                    *(LAS unsigned*)(Pn + ta * ROWB + c0 * 2) = pk2(p0 * ic - bf_lo(xc), p1 * ic - bf_hi(xc));
                }
            }
            LBAR();
            f32x4 acc[2][4];
#pragma unroll
            for (int nt = 0; nt < 2; ++nt)
#pragma unroll
                for (int tt = 0; tt < 4; ++tt) acc[nt][tt] = zero4;
            const int g = wid >> 1;
#pragma unroll
            for (int ks = 0; ks < 2; ++ks) {
                bf16x8 bfr[4];
#pragma unroll
                for (int tt = 0; tt < 4; ++tt) bfr[tt] = *(const LAS bf16x8*)(Pn + (tt * 16 + fr) * ROWB + (g * 64 + ks * 32 + fq * 8) * 2);
#pragma unroll
                for (int nt = 0; nt < 2; ++nt)
#pragma unroll
                    for (int tt = 0; tt < 4; ++tt) acc[nt][tt] = MFMA16(afp[ks][nt], bfr[tt], acc[nt][tt]);
            }
#pragma unroll
            for (int nt = 0; nt < 2; ++nt)
#pragma unroll
                for (int tt = 0; tt < 4; ++tt) {
                    const int ch = wid * 32 + nt * 16 + 4 * fq; const size_t tok = (size_t)(tok0 + tt * 16 + fr);
                    const u32x2 gv = gvp[nt][tt];
                    u32x2 w; w.x = pk2(acc[nt][tt][0] * bf_lo(gv.x), acc[nt][tt][1] * bf_hi(gv.x)); w.y = pk2(acc[nt][tt][2] * bf_lo(gv.y), acc[nt][tt][3] * bf_hi(gv.y));
                    *(u32x2*)(Y + tok * DM + 512 + ch) = w;
                }
        }
        if (MIXMASK & 8) for (int rep_ = 0; rep_ < REP_SGU; ++rep_) {
            if (rep_) LBAR();
            LANE_VARS
            LAS unsigned char* vnT = lds;
            const int cb = (r & ~1) * 64, ph = r & 1;
            const f32x4 lg = *(const f32x4*)(W.sln_g + 4 * lane), lb = *(const f32x4*)(W.sln_b + 4 * lane);
            u32x2 raw[16];
#pragma unroll
            for (int i = 0; i < 16; ++i) raw[i] = *(const u32x2*)(Zb + (size_t)(cb + wid * 16 + i) * DIN + 1792 + 4 * lane);
            const int h = wid >> 1, dh = wid & 1;
            bf16x8 bsw[4][4];
#pragma unroll
            for (int ks = 0; ks < 4; ++ks)
#pragma unroll
                for (int pt = 0; pt < 4; ++pt) bsw[ks][pt] = *(const bf16x8*)(W.SGW + (size_t)(h * 128 + ph * 64 + pt * 16 + fr) * 128 + ks * 32 + fq * 8);
            u32x2 uvv[4][2], gvs[4][2];
#pragma unroll
            for (int pt = 0; pt < 4; ++pt)
#pragma unroll
                for (int dt = 0; dt < 2; ++dt) { const size_t o = (size_t)(tok0 + pt * 16 + fr) * DIN + h * 64 + (2 * dh + dt) * 16 + 4 * fq; uvv[pt][dt] = *(const u32x2*)(Z + o + 1536); gvs[pt][dt] = *(const u32x2*)(Z + o + 2048 + 768); }
            __builtin_amdgcn_sched_barrier(0);
#pragma unroll
            for (int i = 0; i < 16; ++i) {
                const int q = wid * 16 + i;
                const float x0 = bf_lo(raw[i].x), x1 = bf_hi(raw[i].x), x2 = bf_lo(raw[i].y), x3 = bf_hi(raw[i].y);
                const float sm = wave_sum((x0 + x1) + (x2 + x3)), sq = wave_sum((x0 * x0 + x1 * x1) + (x2 * x2 + x3 * x3));
                const float mean = sm * (1.f / 256.f), var = sq * (1.f / 256.f) - mean * mean, rstd = __builtin_amdgcn_rsqf(var + 1e-5f);
                LAS unsigned char* dst = vnT + (4 * lane) * VNT_ROWB + q * 2;
                *(LAS unsigned short*)(dst) = bf1((x0 - mean) * rstd * lg[0] + lb[0]);
                *(LAS unsigned short*)(dst + VNT_ROWB) = bf1((x1 - mean) * rstd * lg[1] + lb[1]);
                *(LAS unsigned short*)(dst + 2 * VNT_ROWB) = bf1((x2 - mean) * rstd * lg[2] + lb[2]);
                *(LAS unsigned short*)(dst + 3 * VNT_ROWB) = bf1((x3 - mean) * rstd * lg[3] + lb[3]);
            }
            LBAR();
            f32x4 acc[2][4];
#pragma unroll
            for (int dt = 0; dt < 2; ++dt)
#pragma unroll
                for (int pt = 0; pt < 4; ++pt) acc[dt][pt] = zero4;
#pragma unroll
            for (int ks = 0; ks < 4; ++ks) {
                bf16x8 af[2];
#pragma unroll
                for (int dt = 0; dt < 2; ++dt) af[dt] = *(const LAS bf16x8*)(vnT + (h * 64 + (2 * dh + dt) * 16 + fr) * VNT_ROWB + (ks * 32 + fq * 8) * 2);
#pragma unroll
                for (int dt = 0; dt < 2; ++dt)
#pragma unroll
                    for (int pt = 0; pt < 4; ++pt) acc[dt][pt] = MFMA16(af[dt], bsw[ks][pt], acc[dt][pt]);
            }
#pragma unroll
            for (int pt = 0; pt < 4; ++pt) {
                const float bsv = W.sgu_b[h * 128 + ph * 64 + pt * 16 + fr]; const size_t tok = (size_t)(tok0 + pt * 16 + fr);
#pragma unroll
                for (int dt = 0; dt < 2; ++dt) {
                    const int ch = h * 64 + (2 * dh + dt) * 16 + 4 * fq;
                    const u32x2 uv = uvv[pt][dt], gv = gvs[pt][dt];
                    u32x2 w; w.x = pk2((acc[dt][pt][0] + bsv) * bf_lo(uv.x) * bf_lo(gv.x), (acc[dt][pt][1] + bsv) * bf_hi(uv.x) * bf_hi(gv.x));
                    w.y = pk2((acc[dt][pt][2] + bsv) * bf_lo(uv.y) * bf_lo(gv.y), (acc[dt][pt][3] + bsv) * bf_hi(uv.y) * bf_hi(gv.y));
                    *(u32x2*)(Y + tok * DM + 768 + ch) = w;
                }
            }
        }
    }
}

__device__ __forceinline__ void final_phase(float* out, const float* ssq, const float* fg) {
    const int tid = threadIdx.x, lane = tid & 63, wave = tid >> 6;
    const int gw = blockIdx.x * NWAVES + wave, NGW = gridDim.x * NWAVES;
    f32x4 g[4];
#pragma unroll
    for (int j = 0; j < 4; ++j) g[j] = *((const f32x4*)fg + lane + 64 * j);
    for (int m = gw; m < M; m += NGW) {
        const f32x4* sp = (const f32x4*)(ssq + (size_t)m * 16);
        const f32x4 st = (sp[0] + sp[1]) + (sp[2] + sp[3]);
        const float rs = __builtin_amdgcn_rsqf(((st[0] + st[1]) + (st[2] + st[3])) * (1.0f / 1024.0f) + 1e-6f);
        f32x4* xr = (f32x4*)(out + (size_t)m * DM) + lane;
        f32x4 v[4];
#pragma unroll
        for (int j = 0; j < 4; ++j) v[j] = xr[64 * j];
#pragma unroll
        for (int j = 0; j < 4; ++j) xr[64 * j] = v[j] * rs * g[j];
    }
}

__global__ void __launch_bounds__(NT, 2) fwd_megakernel(Args a) {
    extern __shared__ __attribute__((aligned(16))) unsigned char lds_raw[];
    LAS unsigned char* lds = (LAS unsigned char*)lds_raw;
    cg::grid_group grid = cg::this_grid();
    volatile LAS unsigned* bst = (volatile LAS unsigned*)(lds + BAR_LDS_OFF);
    if (threadIdx.x < 2) bst[threadIdx.x] = 0u;
    __syncthreads();
    XcdBarrier bar = xcd_barrier_post((unsigned*)a.ws, bst);
    unsigned char* ws = a.ws;
    const int lo = a.ph_lo, hi = a.ph_hi;
#define IN(k) (lo <= (k) && (k) < hi)
#define SEAM(k) do { if (IN(k) && IN((k) + 1)) { if ((k) == 0) grid.sync(); else xcd_barrier(bar); } } while (0)
    bf16_t* XB = (bf16_t*)(ws + WS_XB); bf16_t* Zp = (bf16_t*)(ws + WS_Z); bf16_t* VT = (bf16_t*)(ws + WS_VT); bf16_t* Yp = (bf16_t*)(ws + WS_Y); float* ssq = (float*)(ws + WS_SSQ);
    if ((PHMASK & 1) && IN(0)) { for (int rep = 0; rep < PROREP; ++rep) { prologue(lds, a); __syncthreads(); } }
    SEAM(0);
    for (int l = 0; l < DEPTH; ++l) {
        const int p0 = 1 + 3 * l;
        if ((PHMASK & 2) && IN(p0)) {
            pg8::Gemm g{XB, (const bf16_t*)(ws + WS_WIN) + (size_t)l * DIN * DM, M, DIN, DM}; pg8::StaticOrder S; S.init(M, DIN, (int)gridDim.x, (int)blockIdx.x);
            pg8::EpiZ E{Zp, VT, ssq};
            for (int rep = 0; rep < G1REP; ++rep) pg8::gemm_phase<pg8::EpiZ, pg8::StaticOrder, true, true>(lds, g, S, E);
        }
        SEAM(p0);
        if ((PHMASK & 4) && IN(p0 + 1)) {
            MixW W;
            W.rpb = a.in[3] + (size_t)l * 8 * 465; W.dw_w = a.in[4] + (size_t)l * 31 * 256; W.dw_b = a.in[5] + l * 256; W.cln_g = a.in[6] + l * 256; W.cln_b = a.in[7] + l * 256;
            W.sln_g = a.in[11] + l * 256; W.sln_b = a.in[12] + l * 256; W.sgu_b = a.in[14] + l * 512;
            W.PWT = (const bf16_t*)(ws + WS_PW) + (size_t)l * 65536; W.POOLT = (const bf16_t*)(ws + WS_POOL) + (size_t)l * 16384; W.SGW = (const bf16_t*)(ws + WS_SGW) + (size_t)l * 65536;
            for (int rep = 0; rep < MIXREP; ++rep) mixer_phase(lds, Zp, VT, Yp, W);
            __syncthreads();
        }
        SEAM(p0 + 1);
        if ((PHMASK & 8) && IN(p0 + 2)) {
            pg8::Gemm g{Yp, (const bf16_t*)(ws + WS_WOUT) + (size_t)l * DM * DM, M, DM, DM}; pg8::StaticOrder S; S.init(M, DM, (int)gridDim.x, (int)blockIdx.x);
            pg8::EpiX E{l == 0 ? a.in[0] : a.out, a.out, XB, ssq, l + 1 < DEPTH ? 1 : 0};
            for (int rep = 0; rep < (l == 0 ? G2REP : 1); ++rep) pg8::gemm_phase<pg8::EpiX, pg8::StaticOrder, true, true>(lds, g, S, E);
        }
        SEAM(p0 + 2);
    }
    if ((PHMASK & 16) && IN(7)) final_phase(a.out, ssq, a.in[16]);
#undef IN
#undef SEAM
}

extern "C" void kernel_launch(void* const* d_in, const int* in_sizes, int n_in, void* d_out, int out_size, void* d_ws, size_t ws_size, hipStream_t stream) {
    static int grid = 0;
    if (grid == 0) {
        if (n_in != 17 || in_sizes[0] != M * DM || out_size != M * DM || ws_size < WS_END) { fprintf(stderr, "kernel_launch: unexpected shapes (n_in %d, in0 %d, out %d, ws %zu)\n", n_in, n_in > 0 ? in_sizes[0] : -1, out_size, ws_size); grid = -1; return; }
        int dev = 0, cus = 0, per_cu = 0;
        if (hipGetDevice(&dev) != hipSuccess || hipDeviceGetAttribute(&cus, hipDeviceAttributeMultiprocessorCount, dev) != hipSuccess) { grid = -1; return; }
        if (hipFuncSetAttribute((const void*)fwd_megakernel, hipFuncAttributeMaxDynamicSharedMemorySize, LDS_BYTES) != hipSuccess) { fprintf(stderr, "kernel_launch: hipFuncSetAttribute failed\n"); grid = -1; return; }
        if (hipOccupancyMaxActiveBlocksPerMultiprocessor(&per_cu, (const void*)fwd_megakernel, NT, LDS_BYTES) != hipSuccess || per_cu < 1) { fprintf(stderr, "kernel_launch: occupancy query gave %d\n", per_cu); per_cu = 1; }
        (void)hipGetLastError();
        grid = cus * per_cu;
    }
    if (grid < 0) return;
    Args a{};
    for (int i = 0; i < 17; ++i) a.in[i] = (const float*)d_in[i];
    a.out = (float*)d_out; a.ws = (unsigned char*)d_ws;
    if (MK_N_LAUNCHES == 1) {
        a.ph_lo = 0; a.ph_hi = 8;
        if (hipMemsetAsync(d_ws, 0, 16384, stream) != hipSuccess) { fprintf(stderr, "kernel_launch: memset of the barrier words failed\n"); return; }
        void* args[] = {&a};
        hipError_t e = hipLaunchCooperativeKernel((const void*)fwd_megakernel, dim3(grid), dim3(NT), args, LDS_BYTES, stream);
        if (e != hipSuccess) fprintf(stderr, "cooperative launch failed: %s (grid %d)\n", hipGetErrorString(e), grid);
    } else {
        for (int p = 0; p < 8; ++p) {
            a.ph_lo = p; a.ph_hi = p + 1;
            hipLaunchKernelGGL(fwd_megakernel, dim3(grid), dim3(NT), LDS_BYTES, stream, a);
        }
    }
}
```

```cpp
#include <hip/hip_runtime.h>
#include <hip/hip_cooperative_groups.h>
#include <cstdio>
#include <cstdint>
namespace cg = cooperative_groups;
#ifndef MK_N_LAUNCHES
#define MK_N_LAUNCHES 1
#endif
typedef float f32x2 __attribute__((ext_vector_type(2)));
typedef unsigned u32x2 __attribute__((ext_vector_type(2)));
__device__ __forceinline__ unsigned pk2(float lo, float hi) {
    typedef __bf16 bf2 __attribute__((ext_vector_type(2)));
    bf2 v = __builtin_convertvector((f32x2){lo, hi}, bf2);
    return __builtin_bit_cast(unsigned, v);
}
__device__ __forceinline__ unsigned short bf1(float x) { __bf16 v = (__bf16)x; return __builtin_bit_cast(unsigned short, v); }
__device__ __forceinline__ float bf_lo(unsigned u) { return __uint_as_float(u << 16); }
__device__ __forceinline__ float bf_hi(unsigned u) { return __uint_as_float(u & 0xffff0000u); }
__device__ __forceinline__ float fexp(float x) { return __builtin_amdgcn_exp2f(x * 1.44269504f); }
__device__ __forceinline__ float frcp(float x) { return __builtin_amdgcn_rcpf(x); }
__device__ __forceinline__ float silu_f(float x) { return x * frcp(1.f + fexp(-x)); }
__device__ __forceinline__ float gelu_f(float x) { const float u = 0.7978845608f * (x + 0.044715f * x * x * x); return x * frcp(1.f + fexp(-2.f * u)); }
__device__ __forceinline__ float wave_sum(float v) {
#pragma unroll
    for (int o = 1; o < 64; o <<= 1) v += __shfl_xor(v, o);
    return v;
}
namespace pg8 {
#define PG8_LAS __attribute__((address_space(3)))
typedef unsigned short bf16_t;
typedef short bf16x8 __attribute__((ext_vector_type(8)));
typedef float f32x4 __attribute__((ext_vector_type(4)));
typedef unsigned u32x4 __attribute__((ext_vector_type(4)));
constexpr int BM = 256, BK = 64, HALF = 128, HTB = HALF * BK * 2  , STAGE_BYTES = 8 * HTB, NXCD = 8, WGM = 8;

__host__ __device__ __forceinline__ int lds_byte(int r, int c) { const int st = (r >> 4) * 2 + (c >> 5), rr = r & 15, cc = c & 31, ob = rr * 64 + cc * 2; return st * 1024 + (ob ^ (((ob >> 9) & 1) << 5)); }
__host__ __device__ __forceinline__ void stage_rc(int b, int& R, int& C) { const int st = b / 1024, sb = b % 1024, swz = sb ^ (((sb >> 9) & 1) << 5); R = (st >> 1) * 16 + swz / 64; C = (st & 1) * 32 + (swz % 64) / 2; }
__host__ __device__ __forceinline__ int perm32(int rho) { const int n = rho >> 4, i = rho & 15; return 8 * (i >> 2) + 4 * n + (i & 3); }

struct Unit { int pm, pn; };
struct Gemm { const bf16_t* A; const bf16_t* Bt; int M, N, K; };

struct StaticOrder {
    int nM, nN, nwg, G, c;
    __host__ __device__ void init(int M, int N, int G_, int c_) { nM = M / BM; nN = N / BM; nwg = nM * nN; G = G_; c = c_; }
    __host__ __device__ bool next(int i, Unit& u) const {
        const long L = (long)i * G + c; if (L >= nwg) return false;
        int wgid = (int)L; { const int q = nwg / NXCD, r = nwg % NXCD, xcd = wgid % NXCD, off = wgid / NXCD; wgid = (xcd < r ? xcd * (q + 1) : r * (q + 1) + (xcd - r) * q) + off; }
        const int nig = WGM * nN, gid = wgid / nig, fm = gid * WGM, gsz = (nM - fm) < WGM ? (nM - fm) : WGM;
        u.pm = fm + ((wgid % nig) % gsz); u.pn = (wgid % nig) / gsz; return true;
    }
    __device__ __forceinline__ void a_ready(const Unit&) const {}
    __device__ __forceinline__ void done(const Unit&) const {}
};
struct EpiZ {
    static constexpr bool PERM = true, AFTER_DRAIN = false;
    bf16_t* Z; bf16_t* VT; const float* ssq;
    __device__ __forceinline__ void operator()(const f32x4 (&acc)[2][2][4][2], const Unit& u, int wr, int wc, int fr, int fq) const {
        const int row0 = u.pm * BM + wr * 64 + fr, pn = u.pn, col0 = pn * BM + wc * 32 + 8 * fq;
        const int act = (pn >= 8) ? 2 : (pn >= 6 ? 1 : 0);
#pragma unroll
        for (int ai = 0; ai < 2; ++ai)
#pragma unroll
            for (int m = 0; m < 4; ++m) {
                const int row = row0 + ai * HALF + m * 16;
                const f32x4* sp = (const f32x4*)(ssq + (size_t)row * 16);
                const f32x4 st = (sp[0] + sp[1]) + (sp[2] + sp[3]);
                const float rs = __builtin_amdgcn_rsqf(((st[0] + st[1]) + (st[2] + st[3])) * (1.0f / 1024.0f) + 1e-6f);
#pragma unroll
                for (int bj = 0; bj < 2; ++bj) {
                    f32x4 v0 = acc[ai][bj][m][0] * rs, v1 = acc[ai][bj][m][1] * rs;
                    if (act == 1) {
#pragma unroll
                        for (int e = 0; e < 4; ++e) { v0[e] = gelu_f(v0[e]); v1[e] = gelu_f(v1[e]); }
                    } else if (act == 2) {
#pragma unroll
                        for (int e = 0; e < 4; ++e) { v0[e] = silu_f(v0[e]); v1[e] = silu_f(v1[e]); }
                    }
                    if (pn == 2) {
                        const int b = row >> 11, s = row & 2047, h = 4 * bj + wc;
                        bf16_t* vp = VT + ((size_t)((b * 8 + h) * 32 + 8 * fq)) * 2048 + s;
#pragma unroll
                        for (int e = 0; e < 4; ++e) { vp[(size_t)e * 2048] = bf1(v0[e]); vp[(size_t)(4 + e) * 2048] = bf1(v1[e]); }
                    } else {
                        u32x4 w; w.x = pk2(v0[0], v0[1]); w.y = pk2(v0[2], v0[3]); w.z = pk2(v1[0], v1[1]); w.w = pk2(v1[2], v1[3]);
                        *(u32x4*)(Z + (size_t)row * 3072 + col0 + bj * HALF) = w;
                    }
                }
            }
    }
};
struct EpiX {
    static constexpr bool PERM = false, AFTER_DRAIN = false;
    const float* xin; float* xout; bf16_t* xb; float* ssq; int write_xb;
    __device__ __forceinline__ void operator()(const f32x4 (&acc)[2][2][4][2], const Unit& u, int wr, int wc, int fr, int fq) const {
        const int row0 = u.pm * BM + wr * 64 + fr, col0 = u.pn * BM + wc * 32 + 4 * fq;
#pragma unroll
        for (int ai = 0; ai < 2; ++ai)
#pragma unroll
            for (int m = 0; m < 4; ++m) {
                const int row = row0 + ai * HALF + m * 16; const size_t off = (size_t)row * 1024 + col0;
                float q = 0.f;
#pragma unroll
                for (int bj = 0; bj < 2; ++bj)
#pragma unroll
                    for (int n = 0; n < 2; ++n) {
                        const f32x4 xv = *(const f32x4*)(xin + off + bj * HALF + n * 16);
                        const f32x4 o = xv + acc[ai][bj][m][n];
                        *(f32x4*)(xout + off + bj * HALF + n * 16) = o;
                        q += (o[0] * o[0] + o[1] * o[1]) + (o[2] * o[2] + o[3] * o[3]);
                        if (write_xb) { u32x2 w; w.x = pk2(o[0], o[1]); w.y = pk2(o[2], o[3]); *(u32x2*)(xb + off + bj * HALF + n * 16) = w; }
                    }
                q += __shfl_xor(q, 16); q += __shfl_xor(q, 32);
                if (fq == 0) ssq[(size_t)row * 16 + u.pn * 4 + wc] = q;
            }
    }
};
template <class Epi, class Sched, bool ALIGN_EPI = false, bool SP2 = false>
__device__ __forceinline__ void gemm_phase(PG8_LAS unsigned char* lds, const Gemm g, const Sched& S, const Epi& E) {
    int tid_ = threadIdx.x; asm volatile("" : "+v"(tid_));
    const int tid = tid_, wid = __builtin_amdgcn_readfirstlane(tid >> 6), lane = tid & 63, wr = wid >> 2, wc = wid & 3, fr = lane & 15, fq = lane >> 4;
    const int K = g.K, nt = K / BK;
    unsigned voffA[2], voffB[2];
#pragma unroll
    for (int i = 0; i < 2; ++i) { int R, C; stage_rc(tid * 16 + i * 8192, R, C); const int Rb = Epi::PERM ? ((R & ~31) + perm32(R & 31)) : R;
        voffA[i] = (unsigned)(R * K + C) * 2u; voffB[i] = (unsigned)(Rb * K + C) * 2u; }
    const size_t kstep = (size_t)(BK * 2);
    const size_t hstep = (size_t)HALF * K * 2;
    const size_t tstep = 2 * hstep;
    const unsigned ldsw = (unsigned)wid * 1024u;
    const int aoff = lds_byte(wr * 64 + fr, fq * 8), boff = lds_byte(wc * 32 + fr, fq * 8);
#define PG8_SA(b, h) (((b) * 2 + (h)) * HTB)
#define PG8_SB(b, h) ((4 + (b) * 2 + (h)) * HTB)
#define PG8_STAGE(bufoff, gbase, voff) do { _Pragma("unroll") for (int _i = 0; _i < 2; ++_i) \
        __builtin_amdgcn_global_load_lds((const unsigned*)((const char*)(gbase) + (voff)[_i]), (PG8_LAS unsigned*)(lds + (bufoff) + ldsw + _i * 8192), 16, 0, 0); } while (0)
#define PG8_LDA(dst, b, h) do { _Pragma("unroll") for (int m = 0; m < 4; ++m) _Pragma("unroll") for (int k = 0; k < 2; ++k) dst[m][k] = *(const PG8_LAS bf16x8*)(lds + PG8_SA(b, h) + aoff + m * 2048 + k * 1024); } while (0)
#define PG8_LDB(dst, b, h) do { _Pragma("unroll") for (int n = 0; n < 2; ++n) _Pragma("unroll") for (int k = 0; k < 2; ++k) dst[n][k] = *(const PG8_LAS bf16x8*)(lds + PG8_SB(b, h) + boff + n * 2048 + k * 1024); } while (0)
#define PG8_MMA(ai, bj, At, Bt) do { __builtin_amdgcn_s_setprio(1); _Pragma("unroll") for (int m = 0; m < 4; ++m) _Pragma("unroll") for (int n = 0; n < 2; ++n) _Pragma("unroll") for (int k = 0; k < 2; ++k) \
        acc[ai][bj][m][n] = __builtin_amdgcn_mfma_f32_16x16x32_bf16(Bt[n][k], At[m][k], acc[ai][bj][m][n], 0, 0, 0); __builtin_amdgcn_s_setprio(0); } while (0)
#define PG8_WAIT_V(n) asm volatile("s_waitcnt vmcnt(" #n ")" ::: "memory")
#define PG8_WAIT_L(n) asm volatile("s_waitcnt lgkmcnt(" #n ")" ::: "memory")
#define PG8_BAR __builtin_amdgcn_s_barrier()
#define PG8_SCHED __builtin_amdgcn_sched_barrier(0)
    Unit cur, nxt; int ui = 0;
    if (!S.next(0, cur)) return;
    f32x4 acc[2][2][4][2];
#pragma unroll
    for (int a = 0; a < 2; ++a)
#pragma unroll
        for (int b = 0; b < 2; ++b)
#pragma unroll
            for (int m = 0; m < 4; ++m)
#pragma unroll
                for (int n = 0; n < 2; ++n) acc[a][b][m][n] = (f32x4){0.f, 0.f, 0.f, 0.f};
    bf16x8 At[4][2], B0[2][2], B1[2][2];
    const char* cA = (const char*)g.A + (size_t)cur.pm * tstep; const char* cB = (const char*)g.Bt + (size_t)cur.pn * tstep;
    S.a_ready(cur);
    if constexpr (SP2) {
        PG8_STAGE(PG8_SB(0, 0), cB, voffB); PG8_STAGE(PG8_SB(0, 1), cB + hstep, voffB); PG8_STAGE(PG8_SA(0, 0), cA, voffA); PG8_STAGE(PG8_SA(0, 1), cA + hstep, voffA);
        if (wr == 1) PG8_BAR;
        PG8_WAIT_V(2); PG8_BAR;
        PG8_STAGE(PG8_SB(1, 0), cB + kstep, voffB); PG8_STAGE(PG8_SA(1, 0), cA + kstep, voffA); PG8_STAGE(PG8_SB(1, 1), cB + hstep + kstep, voffB);
        PG8_WAIT_V(6); PG8_BAR;
    } else {
        PG8_STAGE(PG8_SB(0, 0), cB, voffB); PG8_STAGE(PG8_SA(0, 0), cA, voffA); PG8_STAGE(PG8_SB(0, 1), cB + hstep, voffB); PG8_STAGE(PG8_SA(0, 1), cA + hstep, voffA);
        if (wr == 1) PG8_BAR;
        PG8_WAIT_V(4); PG8_BAR;
        PG8_STAGE(PG8_SB(1, 0), cB + kstep, voffB); PG8_STAGE(PG8_SA(1, 0), cA + kstep, voffA); PG8_STAGE(PG8_SB(1, 1), cB + hstep + kstep, voffB);
        PG8_WAIT_V(6); PG8_BAR;
    }
    for (;;) {
        const bool has_next = S.next(ui + 1, nxt);
        const char* nA = has_next ? (const char*)g.A + (size_t)nxt.pm * tstep : cA; const char* nB = has_next ? (const char*)g.Bt + (size_t)nxt.pn * tstep : cB;
        for (int t = 0; t < nt; t += 2) {
            const bool last = (t == nt - 2);
            const char* a1 = cA + (size_t)(t + 1) * kstep;
            const char* a2 = last ? nA : cA + (size_t)(t + 2) * kstep; const char* b2 = last ? nB : cB + (size_t)(t + 2) * kstep;
            const char* a3 = a2 + kstep; const char* b3 = b2 + kstep;
            if (last && has_next) S.a_ready(nxt);
            if constexpr (SP2) {
            PG8_LDB(B0, 0, 0); PG8_LDB(B1, 0, 1); PG8_SCHED; PG8_LDA(At, 0, 0); PG8_STAGE(PG8_SA(1, 1), a1 + hstep, voffA);
            PG8_WAIT_V(8); PG8_WAIT_L(0); PG8_BAR; PG8_MMA(0, 0, At, B0); PG8_MMA(0, 1, At, B1); PG8_BAR; PG8_SCHED;
            PG8_LDA(At, 0, 1); PG8_STAGE(PG8_SB(0, 0), b2, voffB); PG8_STAGE(PG8_SB(0, 1), b2 + hstep, voffB); PG8_STAGE(PG8_SA(0, 0), a2, voffA);
            PG8_WAIT_V(8); PG8_WAIT_L(0); PG8_BAR; PG8_MMA(1, 0, At, B0); PG8_MMA(1, 1, At, B1); PG8_BAR; PG8_SCHED;
            PG8_LDB(B0, 1, 0); PG8_LDB(B1, 1, 1); PG8_SCHED; PG8_LDA(At, 1, 0); PG8_STAGE(PG8_SA(0, 1), a2 + hstep, voffA);
            PG8_WAIT_V(8); PG8_WAIT_L(0); PG8_BAR; PG8_MMA(0, 0, At, B0); PG8_MMA(0, 1, At, B1); PG8_BAR; PG8_SCHED;
            PG8_LDA(At, 1, 1); PG8_STAGE(PG8_SB(1, 0), b3, voffB); PG8_STAGE(PG8_SB(1, 1), b3 + hstep, voffB); PG8_STAGE(PG8_SA(1, 0), a3, voffA);
            PG8_WAIT_V(8); PG8_WAIT_L(0); PG8_BAR; PG8_MMA(1, 0, At, B0); PG8_MMA(1, 1, At, B1); PG8_BAR; PG8_SCHED;
            } else {
            PG8_LDB(B0, 0, 0); PG8_SCHED; PG8_LDA(At, 0, 0); PG8_STAGE(PG8_SA(1, 1), a1 + hstep, voffA);
            PG8_WAIT_L(8); PG8_BAR; PG8_WAIT_L(0); PG8_MMA(0, 0, At, B0); PG8_BAR; PG8_SCHED;
            PG8_LDB(B1, 0, 1); PG8_STAGE(PG8_SB(0, 0), b2, voffB);
            PG8_BAR; PG8_WAIT_L(0); PG8_MMA(0, 1, At, B1); PG8_BAR;
            PG8_LDA(At, 0, 1); PG8_STAGE(PG8_SA(0, 0), a2, voffA);
            PG8_BAR; PG8_WAIT_L(0); PG8_MMA(1, 0, At, B0); PG8_BAR; PG8_SCHED;
            PG8_STAGE(PG8_SB(0, 1), b2 + hstep, voffB);
            PG8_WAIT_V(6); PG8_BAR; PG8_MMA(1, 1, At, B1); PG8_BAR;
            PG8_LDB(B0, 1, 0); PG8_SCHED; PG8_LDA(At, 1, 0); PG8_STAGE(PG8_SA(0, 1), a2 + hstep, voffA);
            PG8_WAIT_L(8); PG8_BAR; PG8_WAIT_L(0); PG8_MMA(0, 0, At, B0); PG8_BAR; PG8_SCHED;
            PG8_LDB(B1, 1, 1); PG8_STAGE(PG8_SB(1, 0), b3, voffB);
            PG8_BAR; PG8_WAIT_L(0); PG8_MMA(0, 1, At, B1); PG8_BAR;
            PG8_LDA(At, 1, 1); PG8_STAGE(PG8_SA(1, 0), a3, voffA);
            PG8_BAR; PG8_WAIT_L(0); PG8_MMA(1, 0, At, B0); PG8_BAR; PG8_SCHED;
            PG8_STAGE(PG8_SB(1, 1), b3 + hstep, voffB);
            PG8_WAIT_V(6); PG8_BAR; PG8_MMA(1, 1, At, B1); PG8_BAR;
            }
        }
        if constexpr (ALIGN_EPI) { if (wr == 0) PG8_BAR; }
        if constexpr (!Epi::AFTER_DRAIN) { E(acc, cur, wr, wc, fr, fq); S.done(cur); }
        if (!has_next) break;
#pragma unroll
        for (int a = 0; a < 2; ++a)
#pragma unroll
            for (int b = 0; b < 2; ++b)
#pragma unroll
                for (int m = 0; m < 4; ++m)
#pragma unroll
                    for (int n = 0; n < 2; ++n) acc[a][b][m][n] = (f32x4){0.f, 0.f, 0.f, 0.f};
        cur = nxt; cA = nA; cB = nB; ++ui;
        if constexpr (ALIGN_EPI) { if (wr == 1) PG8_BAR; }
    }
    PG8_WAIT_V(0);
    if constexpr (!ALIGN_EPI) { if (wr == 0) PG8_BAR; }
    PG8_BAR;
    if constexpr (Epi::AFTER_DRAIN) { E.fused(acc, cur, wr, wc, fr, fq, lds, wid, lane); S.done(cur); }
#undef PG8_SA
#undef PG8_SB
#undef PG8_STAGE
#undef PG8_LDA
#undef PG8_LDB
#undef PG8_MMA
#undef PG8_WAIT_V
#undef PG8_WAIT_L
#undef PG8_BAR
#undef PG8_SCHED
}
}

#define LAS __attribute__((address_space(3)))
typedef unsigned short bf16_t;
typedef short bf16x8 __attribute__((ext_vector_type(8)));
typedef float f32x4 __attribute__((ext_vector_type(4)));
typedef unsigned u32x4 __attribute__((ext_vector_type(4)));
constexpr int NWAVES = 8, NT = NWAVES * 64;
constexpr int M = 16384, DM = 1024, DIN = 3072, SEQ = 2048, DEPTH = 2;
constexpr size_t MiB = 1u << 20;
constexpr size_t WS_WIN = 2 * MiB, WS_WOUT = 14 * MiB, WS_PW = 18 * MiB, WS_POOL = 18 * MiB + 256 * 1024, WS_SGW = 18 * MiB + 512 * 1024;
constexpr size_t WS_SSQ = 19 * MiB, WS_XB = 20 * MiB, WS_Y = 52 * MiB, WS_VT = 84 * MiB, WS_Z = 92 * MiB, WS_END = 188 * MiB;
constexpr int LDS_BYTES = 147456, RPB_OFF = 131072, BAR_LDS_OFF = 146432;
constexpr int L_R0 = 0, L_R1 = 49920, L_R2 = 91904, L_STAT = 129024, ROWB = 528  , VNT_ROWB = 272;
#define MFMA16(a, b, c) __builtin_amdgcn_mfma_f32_16x16x32_bf16((a), (b), (c), 0, 0, 0)
#define LDS_WAIT() asm volatile("s_waitcnt lgkmcnt(0)" ::: "memory")
#define LBAR() do { asm volatile("s_waitcnt lgkmcnt(0)" ::: "memory"); __builtin_amdgcn_s_barrier(); asm volatile("" ::: "memory"); } while (0)

#ifndef G2REP
#define G2REP 1
#endif
#ifndef G1REP
#define G1REP 1
#endif
#ifndef PROREP
#define PROREP 1
#endif
#ifndef USE_CG_SYNC
#define USE_CG_SYNC 0
#endif
#ifndef NA_PROBE_VAR
#define NA_PROBE_VAR 0
#endif
#ifndef REP_NA
#define REP_NA 1
#endif
#ifndef REP_CONV
#define REP_CONV 1
#endif
#ifndef REP_POOL
#define REP_POOL 1
#endif
#ifndef REP_SGU
#define REP_SGU 1
#endif
#ifndef NA_UNROLL
#define NA_UNROLL 4
#endif
#ifndef MIXREP
#define MIXREP 1
#endif
#ifndef MIXMASK
#define MIXMASK 15
#endif
#ifndef PHMASK
#define PHMASK 31
#endif
struct Args { const float* in[17]; float* out; unsigned char* ws; int ph_lo, ph_hi; };

#define XB_TMO      128
#define XB_XCNT(j)  (256  + 64 * (j))
#define XB_XSUB(j)  (1280 + 64 * (j))
#define XB_XGEN(j)  (2304 + 64 * (j))
#define XB_TOP      3328
#define XB_TOPGEN   3392
#define XCD_BAR_WORDS 3456
#define XB_SPIN_CAP (1u << 18)

__device__ __forceinline__ unsigned xb_ld(unsigned* p)              { return __hip_atomic_load(p, __ATOMIC_RELAXED, __HIP_MEMORY_SCOPE_AGENT); }
__device__ __forceinline__ unsigned xb_add(unsigned* p, unsigned v) { return __hip_atomic_fetch_add(p, v, __ATOMIC_RELAXED, __HIP_MEMORY_SCOPE_AGENT); }
__device__ __forceinline__ unsigned xb_xcc_id() { return (unsigned)__builtin_amdgcn_s_getreg((3 << 11) | 20) & 0xFu; }
#define XB_SPIN(cond, bar) do { unsigned _sp = 0; while (cond) { __builtin_amdgcn_s_sleep(1); \
    if ((++_sp & 255u) == 0u) { if (xb_ld(&(bar)[XB_TMO])) break; if (_sp > XB_SPIN_CAP) { atomicAdd(&(bar)[XB_TMO], 1u); break; } } } } while (0)

struct XcdBarrier {
    unsigned* bar; unsigned x;
    volatile LAS unsigned* st;
};

__device__ __forceinline__ XcdBarrier xcd_barrier_post(unsigned* bar, volatile LAS unsigned* st) {
    XcdBarrier b; b.bar = bar; b.x = xb_xcc_id(); b.st = st;
    if (threadIdx.x == 0) (void)xb_add(&bar[XB_XCNT(b.x)], 1u);
    return b;
}
__device__ __forceinline__ void xcd_barrier_complete(unsigned* bar, unsigned x, unsigned& nloc, unsigned& nx) {
    const unsigned G = gridDim.x * gridDim.y * gridDim.z;
    unsigned sum, cnt, mine, sp = 0u;
    for (;;) {
        sum = 0u; cnt = 0u; mine = 0u;
#pragma unroll
        for (unsigned j = 0; j < 16; ++j) { const unsigned c = xb_ld(&bar[XB_XCNT(j)]); sum += c; cnt += (c > 0u) ? 1u : 0u; mine = (j == x) ? c : mine; }
        if (sum == G) break;
        __builtin_amdgcn_s_sleep(1);
        if ((++sp & 255u) == 0u) { if (xb_ld(&bar[XB_TMO])) break; if (sp > XB_SPIN_CAP) { atomicAdd(&bar[XB_TMO], 1u); break; } }
    }
    nloc = mine > 0u ? mine : 1u; nx = cnt > 0u ? cnt : 1u;
}

__device__ __forceinline__ void xcd_barrier(const XcdBarrier& b) {
    asm volatile("s_waitcnt vmcnt(0)" ::: "memory");
    __syncthreads();
    if (threadIdx.x == 0) {
        unsigned* bar = b.bar;
        __builtin_amdgcn_s_waitcnt(0);
        unsigned nloc = b.st[0], nx = b.st[1];
        if (nloc == 0u) { xcd_barrier_complete(bar, b.x, nloc, nx); b.st[0] = nloc; b.st[1] = nx; }
        const unsigned old = xb_add(&bar[XB_XSUB(b.x)], 1u);
        const unsigned gen = old / nloc;
        if (old + 1u == (gen + 1u) * nloc) {
            __builtin_amdgcn_fence(__ATOMIC_RELEASE, "agent");
            asm volatile("s_waitcnt vmcnt(0)" ::: "memory");
            const unsigned og = xb_add(&bar[XB_TOP], 1u);
            const unsigned tg = og / nx;
            if (og + 1u == (tg + 1u) * nx) xb_add(&bar[XB_TOPGEN], 1u);
            else XB_SPIN(xb_ld(&bar[XB_TOPGEN]) == tg, bar);
            __builtin_amdgcn_fence(__ATOMIC_ACQUIRE, "agent");
            xb_add(&bar[XB_XGEN(b.x)], 1u);
            asm volatile("s_waitcnt vmcnt(0)" ::: "memory");
        } else {
            XB_SPIN(xb_ld(&bar[XB_XGEN(b.x)]) == gen, bar);
            __builtin_amdgcn_fence(__ATOMIC_ACQUIRE, "agent");
            asm volatile("s_waitcnt vmcnt(0)" ::: "memory");
        }
    }
    __syncthreads();
}

__device__ __forceinline__ void transpose_item(const float* W, int K, int N, bf16_t* WT, LAS float* scr, int item, int lane, const float* ks, const float* ns, int qcols) {
    const int nblk = N / 32, kb = item / nblk, nb = item % nblk, k0 = 64 * kb, n0 = 32 * nb, n = n0 + (lane & 31);
    float nsv = ns ? ns[n] : 1.f; if (n < qcols) nsv *= 0.17677669529663687f;
#pragma unroll 8
    for (int i = 0; i < 32; ++i) { const int kk = 2 * i + (lane >> 5); const float kv = ks ? ks[k0 + kk] : 1.f; scr[kk * 33 + (lane & 31)] = W[(size_t)(k0 + kk) * N + n] * (kv * nsv); }
    LDS_WAIT(); asm volatile("" ::: "memory");
    const int c = lane & 7;
#pragma unroll
    for (int j = 0; j < 4; ++j) { const int nn = (lane >> 3) + 8 * j; const LAS float* s = scr + (8 * c) * 33 + nn;
        u32x4 o; o.x = pk2(s[0 * 33], s[1 * 33]); o.y = pk2(s[2 * 33], s[3 * 33]); o.z = pk2(s[4 * 33], s[5 * 33]); o.w = pk2(s[6 * 33], s[7 * 33]);
        *(u32x4*)(WT + (size_t)(n0 + nn) * K + k0 + 8 * c) = o; }
    LDS_WAIT(); asm volatile("" ::: "memory");
}
__device__ __forceinline__ void prologue(LAS unsigned char* lds, const Args& a) {
    const int tid = threadIdx.x, lane = tid & 63, wave = __builtin_amdgcn_readfirstlane(tid >> 6);
    LAS float* scr = (LAS float*)(lds + wave * 16384);
    const int gw = blockIdx.x * NWAVES + wave, NGW = gridDim.x * NWAVES;
    unsigned char* ws = a.ws;
    constexpr int I_IN = 16 * 96, I_OUT = 16 * 32, I_PW = 4 * 8, I_PL = 2, PER_L = I_IN + I_OUT + I_PW + 4 * I_PL;
    for (int it = gw; it < DEPTH * PER_L; it += NGW) {
        const int l = it / PER_L; int r = it % PER_L;
        if (r < I_IN) { transpose_item(a.in[2] + (size_t)l * DM * DIN, DM, DIN, (bf16_t*)(ws + WS_WIN) + (size_t)l * DIN * DM, scr, r, lane, a.in[1] + l * DM, nullptr, 256); continue; } r -= I_IN;
        if (r < I_OUT) { transpose_item(a.in[15] + (size_t)l * DM * DM, DM, DM, (bf16_t*)(ws + WS_WOUT) + (size_t)l * DM * DM, scr, r, lane, nullptr, nullptr, 0); continue; } r -= I_OUT;
        if (r < I_PW) { transpose_item(a.in[8] + (size_t)l * 65536, 256, 256, (bf16_t*)(ws + WS_PW) + (size_t)l * 65536, scr, r, lane, nullptr, nullptr, 0); continue; } r -= I_PW;
        { const int g = r / I_PL, i = r % I_PL;
          transpose_item(a.in[9] + (size_t)(l * 4 + g) * 4096, 64, 64, (bf16_t*)(ws + WS_POOL) + (size_t)(l * 4 + g) * 4096, scr, i, lane, nullptr, a.in[10] + l * 256 + g * 64, 0); }
    }
    { const float* src = a.in[13]; bf16_t* dst = (bf16_t*)(ws + WS_SGW);
      for (int i = (blockIdx.x * NT + tid) * 4; i < DEPTH * 65536; i += gridDim.x * NT * 4) { const f32x4 v = *(const f32x4*)(src + i); u32x2 w; w.x = pk2(v[0], v[1]); w.y = pk2(v[2], v[3]); *(u32x2*)(dst + i) = w; } }
    { const float* x = a.in[0]; bf16_t* xb = (bf16_t*)(ws + WS_XB); float* ssq = (float*)(ws + WS_SSQ);
      for (int m = gw; m < M; m += NGW) {
          const f32x4* xr = (const f32x4*)(x + (size_t)m * DM) + lane; f32x4 v[4]; float s = 0.f;
#pragma unroll
          for (int j = 0; j < 4; ++j) { v[j] = xr[64 * j]; s += (v[j][0] * v[j][0] + v[j][1] * v[j][1]) + (v[j][2] * v[j][2] + v[j][3] * v[j][3]); }
          s = wave_sum(s);
          u32x2* o = (u32x2*)(xb + (size_t)m * DM) + lane;
#pragma unroll
          for (int j = 0; j < 4; ++j) { u32x2 w; w.x = pk2(v[j][0], v[j][1]); w.y = pk2(v[j][2], v[j][3]); o[64 * j] = w; }
          if (lane < 16) ssq[(size_t)m * 16 + lane] = (lane == 0) ? s : 0.f;
      } }
}

struct MixW { const float *rpb, *dw_w, *dw_b, *cln_g, *cln_b, *sln_g, *sln_b, *sgu_b; const bf16_t *PWT, *POOLT, *SGW; };

#define LANE_VARS int tid = tid0; asm volatile("" : "+v"(tid)); const int lane = tid & 63, fr = lane & 15, fq = lane >> 4, c0 = half * 128 + 2 * lane; (void)fr; (void)fq; (void)c0;
template <int nav>
__device__ __forceinline__ void na_stage(const bf16_t* Z, const bf16_t* Zb, const bf16_t* VT, bf16_t* Y, LAS float* rpbL, int b, int r, int tok0, int wid, int tid0, int half) {
    const f32x4 zero4 = {0.f, 0.f, 0.f, 0.f};
    {
            LANE_VARS
            const int h = wid, rs = min(max(r - 4, 0), 24);
            const bf16_t* VTh = VT + (size_t)(b * 8 + h) * 32 * SEQ;
            const int kperm = (fr >> 2) * 8 + (fr & 3);
#define NA_CW0(qb) ((qb) == 0 ? 0 : ((qb) == 1 ? 8 : ((qb) == 2 ? 24 : 32)))
            const int klane = kperm * DIN + fq * 8, qlane = fr * DIN + fq * 8, vlane = fr * SEQ + fq * 8, glane = fr * DIN + 4 * fq;
            const bf16_t* Kh = Zb + (size_t)rs * 64 * DIN + 256 + h * 32;
#define NA_KLOAD(dst, qb) do { _Pragma("unroll") for (int j = 0; j < 8; ++j) _Pragma("unroll") for (int t = 0; t < 2; ++t) \
                dst[j][t] = *(const bf16x8*)((Kh + (size_t)(j * 64 + NA_CW0(qb) + t * 4) * DIN) + klane); } while (0)
#define NA_QLOAD(qb) (*(const bf16x8*)((Zb + (size_t)(r * 64 + 16 * (qb)) * DIN + h * 32) + qlane))
            bf16x8 qcur = NA_QLOAD(0), qnxt = qcur;
            bf16x8 kf[8][2];
            if (nav != 1) NA_KLOAD(kf, 0); else { _Pragma("unroll") for (int j = 0; j < 8; ++j) { kf[j][0] = qcur; kf[j][1] = qcur; } }
            __builtin_amdgcn_sched_barrier(0);
#pragma unroll
            for (int qb = 0; qb < 4; ++qb) {
                const int c = 16 * qb + fr, cw0 = NA_CW0(qb), cs = min(max(c - 8, 0), 48);
                f32x4 S[8][2];
#pragma unroll
                for (int j = 0; j < 8; ++j)
#pragma unroll
                    for (int t = 0; t < 2; ++t) S[j][t] = MFMA16(kf[j][t], qcur, zero4);
                __builtin_amdgcn_sched_barrier(0);
                bf16x8 vf[8][2];
#pragma unroll
                for (int j = 0; j < 8; ++j)
#pragma unroll
                    for (int dt = 0; dt < 2; ++dt) { if (nav != 1) vf[j][dt] = *(const bf16x8*)((VTh + (size_t)(dt * 16) * SEQ + (rs + j) * 64 + cw0) + vlane); else vf[j][dt] = qcur; }
                u32x2 gv[2];
#pragma unroll
                for (int dt = 0; dt < 2; ++dt) gv[dt] = *(const u32x2*)((Z + (size_t)(tok0 + 16 * qb) * DIN + 2048 + h * 32 + dt * 16) + glane);
                __builtin_amdgcn_sched_barrier(0);
                float mx = -INFINITY;
                if (nav != 2)
#pragma unroll
                for (int j = 0; j < 8; ++j) {
                    const LAS float* rp = rpbL + h * 465 + (rs + j - r + 7) * 31 + 15;
#pragma unroll
                    for (int t = 0; t < 2; ++t)
#pragma unroll
                        for (int e = 0; e < 4; ++e) {
                            const int kc = cw0 + fq * 8 + t * 4 + e; const bool valid = (kc >= cs) && (kc < cs + 16);
                            const int dc = min(max(kc - c, -15), 15);
                            float sv = S[j][t][e] + rp[dc]; sv = valid ? sv : -INFINITY; S[j][t][e] = sv; mx = fmaxf(mx, sv);
                        }
                    if (j & 1) __builtin_amdgcn_sched_barrier(0);
                }
                mx = fmaxf(mx, __shfl_xor(mx, 16)); mx = fmaxf(mx, __shfl_xor(mx, 32));
                float sum = (nav == 2) ? 1.f : 0.f;
                if (nav != 2)
#pragma unroll
                for (int j = 0; j < 8; ++j)
#pragma unroll
                    for (int t = 0; t < 2; ++t)
#pragma unroll
                        for (int e = 0; e < 4; ++e) { const float p = __builtin_amdgcn_exp2f((S[j][t][e] - mx) * 1.44269504f); S[j][t][e] = p; sum += p; }
                sum += __shfl_xor(sum, 16); sum += __shfl_xor(sum, 32);
                const float inv = frcp(sum);
                f32x4 O[2] = {zero4, zero4};
                bf16x8 pf[8];
#pragma unroll
                for (int j = 0; j < 8; ++j) {
                    u32x4 pw; pw.x = pk2(S[j][0][0], S[j][0][1]); pw.y = pk2(S[j][0][2], S[j][0][3]); pw.z = pk2(S[j][1][0], S[j][1][1]); pw.w = pk2(S[j][1][2], S[j][1][3]);
                    pf[j] = __builtin_bit_cast(bf16x8, pw);
                }
                __builtin_amdgcn_sched_barrier(0);
                if (qb < 3) { qnxt = NA_QLOAD(qb + 1); if (nav != 1) NA_KLOAD(kf, qb + 1); }
                __builtin_amdgcn_sched_barrier(0);
#pragma unroll
                for (int j = 0; j < 8; ++j)
#pragma unroll
                    for (int dt = 0; dt < 2; ++dt) O[dt] = MFMA16(vf[j][dt], pf[j], O[dt]);
#pragma unroll
                for (int dt = 0; dt < 2; ++dt) {
                    const int ch = h * 32 + dt * 16 + 4 * fq;
                    u32x2 w; w.x = pk2(O[dt][0] * inv * bf_lo(gv[dt].x), O[dt][1] * inv * bf_hi(gv[dt].x)); w.y = pk2(O[dt][2] * inv * bf_lo(gv[dt].y), O[dt][3] * inv * bf_hi(gv[dt].y));
                    *(u32x2*)(Y + (size_t)(tok0 + c) * DM + ch) = w;
                }
                qcur = qnxt;
                __builtin_amdgcn_sched_barrier(0);
            }
            }
}

__device__ __forceinline__ void mixer_phase(LAS unsigned char* lds, const bf16_t* Z, const bf16_t* VT, bf16_t* Y, const MixW& W) {
    const int tid0 = threadIdx.x, wid = __builtin_amdgcn_readfirstlane(tid0 >> 6);
    LAS float* rpbL = (LAS float*)(lds + RPB_OFF);
    for (int i = tid0; i < 8 * 465; i += NT) rpbL[i] = W.rpb[i];
    const f32x4 zero4 = {0.f, 0.f, 0.f, 0.f};
    const int tq = wid >> 1, half = wid & 1;
    for (int item = blockIdx.x; item < 256; item += gridDim.x) {
        LBAR();
        const int b = item & 7, r = item >> 3, tok0 = b * SEQ + r * 64;
        const bf16_t* Zb = Z + (size_t)b * SEQ * DIN;
        if (MIXMASK & 1) {
            for (int rep_ = 0; rep_ + 1 < REP_NA; ++rep_) { na_stage<NA_PROBE_VAR>(Z, Zb, VT, Y, rpbL, b, r, tok0, wid, tid0, half); LBAR(); }
            na_stage<0>(Z, Zb, VT, Y, rpbL, b, r, tok0, wid, tid0, half);
        }
        if (MIXMASK & 2) for (int rep_ = 0; rep_ < REP_CONV; ++rep_) {
            if (rep_) LBAR();
            LANE_VARS
            LAS unsigned char* Hb = lds + L_R0; LAS unsigned char* Hn = lds + L_R0; LAS unsigned char* Cf = lds + L_R1; LAS f32x2* stat = (LAS f32x2*)(lds + L_STAT);
            {
                u32x4 av[6], bv[6];
#pragma unroll
                for (int k = 0; k < 6; ++k) {
                    const int task = tid + k * NT, tt = task >> 5, ch = task & 31, s = r * 64 - 15 + tt;
                    av[k] = (u32x4){0u, 0u, 0u, 0u}; bv[k] = av[k];
                    if (task < 94 * 32 && s >= 0 && s < SEQ) { av[k] = *(const u32x4*)(Zb + (size_t)s * DIN + 768 + ch * 8); bv[k] = *(const u32x4*)(Zb + (size_t)s * DIN + 1024 + ch * 8); }
                }
                __builtin_amdgcn_sched_barrier(0);
#pragma unroll
                for (int k = 0; k < 6; ++k) {
                    const int task = tid + k * NT, tt = task >> 5, ch = task & 31;
                    u32x4 o;
#pragma unroll
                    for (int e = 0; e < 4; ++e) { const float a0 = bf_lo(av[k][e]), a1 = bf_hi(av[k][e]), b0 = bf_lo(bv[k][e]), b1 = bf_hi(bv[k][e]);
                        o[e] = pk2(a0 * frcp(1.f + fexp(-b0)), a1 * frcp(1.f + fexp(-b1))); }
                    if (task < 94 * 32) *(LAS u32x4*)(Hb + tt * ROWB + ch * 16) = o;
                }
            }
            f32x2 wv[31];
#pragma unroll
            for (int j = 0; j < 31; ++j) wv[j] = *(const f32x2*)(W.dw_w + j * 256 + c0);
            const f32x2 bias = *(const f32x2*)(W.dw_b + c0);
            __builtin_amdgcn_sched_barrier(0);
            LBAR();
#pragma unroll 1
            for (int p = 0; p < 2; ++p) {
                const int tb = tq * 16 + p * 8;
                float a0[8], a1[8];
#pragma unroll
                for (int t = 0; t < 8; ++t) { a0[t] = bias[0]; a1[t] = bias[1]; }
#pragma unroll
                for (int jg = 0; jg < 40; jg += 8) {
                    unsigned hv[8];
#pragma unroll
                    for (int i = 0; i < 8; ++i) if (jg + i < 38) hv[i] = *(const LAS unsigned*)(Hb + (tb + jg + i) * ROWB + c0 * 2);
#pragma unroll
                    for (int i = 0; i < 8; ++i) if (jg + i < 38) {
                        const int jj = jg + i; const float v0 = bf_lo(hv[i]), v1 = bf_hi(hv[i]);
#pragma unroll
                        for (int t = 0; t < 8; ++t) { const int tap = jj - t; if (tap >= 0 && tap <= 30) { a0[t] += v0 * wv[tap][0]; a1[t] += v1 * wv[tap][1]; } }
                    }
                    __builtin_amdgcn_sched_barrier(0);
                }
#pragma unroll
                for (int t = 0; t < 8; ++t) {
                    const float s1 = wave_sum(a0[t] + a1[t]), s2 = wave_sum(a0[t] * a0[t] + a1[t] * a1[t]);
                    if (lane == 0) stat[(tb + t) * 2 + half] = (f32x2){s1, s2};
                    *(LAS f32x2*)(Cf + ((tb + t) * 256 + c0) * 4) = (f32x2){a0[t], a1[t]};
                }
            }
            const f32x2 lg = *(const f32x2*)(W.cln_g + c0), lb = *(const f32x2*)(W.cln_b + c0);
            bf16x8 afw[8][2];
#pragma unroll
            for (int ks = 0; ks < 8; ++ks)
#pragma unroll
                for (int nt = 0; nt < 2; ++nt) afw[ks][nt] = *(const bf16x8*)(W.PWT + (size_t)(wid * 32 + nt * 16 + fr) * 256 + ks * 32 + fq * 8);
            u32x2 gvv[2][4];
#pragma unroll
            for (int nt = 0; nt < 2; ++nt)
#pragma unroll
                for (int tt = 0; tt < 4; ++tt) gvv[nt][tt] = *(const u32x2*)(Z + (size_t)(tok0 + tt * 16 + fr) * DIN + 2048 + 256 + wid * 32 + nt * 16 + 4 * fq);
            __builtin_amdgcn_sched_barrier(0);
            LBAR();
#pragma unroll 4
            for (int t = 0; t < 16; ++t) {
                const f32x2 p = stat[(tq * 16 + t) * 2], q = stat[(tq * 16 + t) * 2 + 1];
                const f32x2 cv = *(const LAS f32x2*)(Cf + ((tq * 16 + t) * 256 + c0) * 4);
                const float mean = (p[0] + q[0]) * (1.f / 256.f), var = (p[1] + q[1]) * (1.f / 256.f) - mean * mean, rstd = __builtin_amdgcn_rsqf(var + 1e-5f);
                const float y0 = (cv[0] - mean) * rstd * lg[0] + lb[0], y1 = (cv[1] - mean) * rstd * lg[1] + lb[1];
                *(LAS unsigned*)(Hn + (tq * 16 + t) * ROWB + c0 * 2) = pk2(silu_f(y0), silu_f(y1));
            }
            LBAR();
            f32x4 acc[2][4];
#pragma unroll
            for (int nt = 0; nt < 2; ++nt)
#pragma unroll
                for (int tt = 0; tt < 4; ++tt) acc[nt][tt] = zero4;
#pragma unroll
            for (int ks = 0; ks < 8; ++ks) {
                bf16x8 bfr[4];
#pragma unroll
                for (int tt = 0; tt < 4; ++tt) bfr[tt] = *(const LAS bf16x8*)(Hn + (tt * 16 + fr) * ROWB + (ks * 32 + fq * 8) * 2);
#pragma unroll
                for (int nt = 0; nt < 2; ++nt)
#pragma unroll
                    for (int tt = 0; tt < 4; ++tt) acc[nt][tt] = MFMA16(afw[ks][nt], bfr[tt], acc[nt][tt]);
            }
#pragma unroll
            for (int nt = 0; nt < 2; ++nt)
#pragma unroll
                for (int tt = 0; tt < 4; ++tt) {
                    const int ch = wid * 32 + nt * 16 + 4 * fq; const size_t tok = (size_t)(tok0 + tt * 16 + fr);
                    const u32x2 gv = gvv[nt][tt];
                    u32x2 w; w.x = pk2(acc[nt][tt][0] * bf_lo(gv.x), acc[nt][tt][1] * bf_hi(gv.x)); w.y = pk2(acc[nt][tt][2] * bf_lo(gv.y), acc[nt][tt][3] * bf_hi(gv.y));
                    *(u32x2*)(Y + tok * DM + 256 + ch) = w;
                }
        }
        if (MIXMASK & 4) for (int rep_ = 0; rep_ < REP_POOL; ++rep_) {
            if (rep_) LBAR();
            LANE_VARS
            LAS unsigned char* Pin = lds + L_R1; LAS unsigned char* Pn = lds + L_R2;
            {
                u32x4 pv[5];
#pragma unroll
                for (int k = 0; k < 5; ++k) {
                    const int task = tid + k * NT, tt = task >> 5, ch = task & 31, s = r * 64 - 8 + tt;
                    pv[k] = (u32x4){0u, 0u, 0u, 0u};
                    if (task < 79 * 32 && s >= 0 && s < SEQ) pv[k] = *(const u32x4*)(Zb + (size_t)s * DIN + 1280 + ch * 8);
                }
                __builtin_amdgcn_sched_barrier(0);
#pragma unroll
                for (int k = 0; k < 5; ++k) { const int task = tid + k * NT, tt = task >> 5, ch = task & 31; if (task < 79 * 32) *(LAS u32x4*)(Pin + tt * ROWB + ch * 16) = pv[k]; }
            }
            bf16x8 afp[2][2];
#pragma unroll
            for (int ks = 0; ks < 2; ++ks)
#pragma unroll
                for (int nt = 0; nt < 2; ++nt) afp[ks][nt] = *(const bf16x8*)(W.POOLT + (size_t)(wid * 32 + nt * 16 + fr) * 64 + ks * 32 + fq * 8);
            u32x2 gvp[2][4];
#pragma unroll
            for (int nt = 0; nt < 2; ++nt)
#pragma unroll
                for (int tt = 0; tt < 4; ++tt) gvp[nt][tt] = *(const u32x2*)(Z + (size_t)(tok0 + tt * 16 + fr) * DIN + 2048 + 512 + wid * 32 + nt * 16 + 4 * fq);
            __builtin_amdgcn_sched_barrier(0);
            LBAR();
            {
                const int g = half * 2 + (lane >> 5), w = 2 << g, hw = w >> 1;
#pragma unroll 4
                for (int t = 0; t < 16; ++t) {
                    const int ta = tq * 16 + t, s = r * 64 + ta;
                    const int lo = max(s - hw, 0), hi = min(s - hw + w, SEQ);
                    float p0 = 0.f, p1 = 0.f;
#pragma unroll
                    for (int i = 0; i < 16; ++i) if (i < w) { const unsigned v = *(const LAS unsigned*)(Pin + (ta + 8 - hw + i) * ROWB + c0 * 2); p0 += bf_lo(v); p1 += bf_hi(v); }
                    const unsigned xc = *(const LAS unsigned*)(Pin + (ta + 8) * ROWB + c0 * 2);
                    const float ic = 1.f / (float)(hi - lo);
                    *(LAS unsigned*)(Pn + ta * ROWB + c0 * 2) = pk2(p0 * ic - bf_lo(xc), p1 * ic - bf_hi(xc));
                }
            }
            LBAR();
            f32x4 acc[2][4];
#pragma unroll
            for (int nt = 0; nt < 2; ++nt)
#pragma unroll
                for (int tt = 0; tt < 4; ++tt) acc[nt][tt] = zero4;
            const int g = wid >> 1;
#pragma unroll
            for (int ks = 0; ks < 2; ++ks) {
                bf16x8 bfr[4];
#pragma unroll
                for (int tt = 0; tt < 4; ++tt) bfr[tt] = *(const LAS bf16x8*)(Pn + (tt * 16 + fr) * ROWB + (g * 64 + ks * 32 + fq * 8) * 2);
#pragma unroll
                for (int nt = 0; nt < 2; ++nt)
#pragma unroll
                    for (int tt = 0; tt < 4; ++tt) acc[nt][tt] = MFMA16(afp[ks][nt], bfr[tt], acc[nt][tt]);
            }
#pragma unroll
            for (int nt = 0; nt < 2; ++nt)
#pragma unroll
                for (int tt = 0; tt < 4; ++tt) {
                    const int ch = wid * 32 + nt * 16 + 4 * fq; const size_t tok = (size_t)(tok0 + tt * 16 + fr);
                    const u32x2 gv = gvp[nt][tt];
                    u32x2 w; w.x = pk2(acc[nt][tt][0] * bf_lo(gv.x), acc[nt][tt][1] * bf_hi(gv.x)); w.y = pk2(acc[nt][tt][2] * bf_lo(gv.y), acc[nt][tt][3] * bf_hi(gv.y));
                    *(u32x2*)(Y + tok * DM + 512 + ch) = w;
                }
        }
        if (MIXMASK & 8) for (int rep_ = 0; rep_ < REP_SGU; ++rep_) {
            if (rep_) LBAR();
            LANE_VARS
            LAS unsigned char* vnT = lds;
            const int cb = (r & ~1) * 64, ph = r & 1;
            const f32x4 lg = *(const f32x4*)(W.sln_g + 4 * lane), lb = *(const f32x4*)(W.sln_b + 4 * lane);
            u32x2 raw[16];
#pragma unroll
            for (int i = 0; i < 16; ++i) raw[i] = *(const u32x2*)(Zb + (size_t)(cb + wid * 16 + i) * DIN + 1792 + 4 * lane);
            const int h = wid >> 1, dh = wid & 1;
            bf16x8 bsw[4][4];
#pragma unroll
            for (int ks = 0; ks < 4; ++ks)
#pragma unroll
                for (int pt = 0; pt < 4; ++pt) bsw[ks][pt] = *(const bf16x8*)(W.SGW + (size_t)(h * 128 + ph * 64 + pt * 16 + fr) * 128 + ks * 32 + fq * 8);
            u32x2 uvv[4][2], gvs[4][2];
#pragma unroll
            for (int pt = 0; pt < 4; ++pt)
#pragma unroll
                for (int dt = 0; dt < 2; ++dt) { const size_t o = (size_t)(tok0 + pt * 16 + fr) * DIN + h * 64 + (2 * dh + dt) * 16 + 4 * fq; uvv[pt][dt] = *(const u32x2*)(Z + o + 1536); gvs[pt][dt] = *(const u32x2*)(Z + o + 2048 + 768); }
            __builtin_amdgcn_sched_barrier(0);
#pragma unroll
            for (int i = 0; i < 16; ++i) {
                const int q = wid * 16 + i;
                const float x0 = bf_lo(raw[i].x), x1 = bf_hi(raw[i].x), x2 = bf_lo(raw[i].y), x3 = bf_hi(raw[i].y);
                const float sm = wave_sum((x0 + x1) + (x2 + x3)), sq = wave_sum((x0 * x0 + x1 * x1) + (x2 * x2 + x3 * x3));
                const float mean = sm * (1.f / 256.f), var = sq * (1.f / 256.f) - mean * mean, rstd = __builtin_amdgcn_rsqf(var + 1e-5f);
                LAS unsigned char* dst = vnT + (4 * lane) * VNT_ROWB + q * 2;
                *(LAS unsigned short*)(dst) = bf1((x0 - mean) * rstd * lg[0] + lb[0]);
                *(LAS unsigned short*)(dst + VNT_ROWB) = bf1((x1 - mean) * rstd * lg[1] + lb[1]);
                *(LAS unsigned short*)(dst + 2 * VNT_ROWB) = bf1((x2 - mean) * rstd * lg[2] + lb[2]);
                *(LAS unsigned short*)(dst + 3 * VNT_ROWB) = bf1((x3 - mean) * rstd * lg[3] + lb[3]);
            }
            LBAR();
            f32x4 acc[2][4];
#pragma unroll
            for (int dt = 0; dt < 2; ++dt)
#pragma unroll
                for (int pt = 0; pt < 4; ++pt) acc[dt][pt] = zero4;
#pragma unroll
            for (int ks = 0; ks < 4; ++ks) {
                bf16x8 af[2];
#pragma unroll
                for (int dt = 0; dt < 2; ++dt) af[dt] = *(const LAS bf16x8*)(vnT + (h * 64 + (2 * dh + dt) * 16 + fr) * VNT_ROWB + (ks * 32 + fq * 8) * 2);
#pragma unroll
                for (int dt = 0; dt < 2; ++dt)
#pragma unroll
                    for (int pt = 0; pt < 4; ++pt) acc[dt][pt] = MFMA16(af[dt], bsw[ks][pt], acc[dt][pt]);
            }
#pragma unroll
            for (int pt = 0; pt < 4; ++pt) {
                const float bsv = W.sgu_b[h * 128 + ph * 64 + pt * 16 + fr]; const size_t tok = (size_t)(tok0 + pt * 16 + fr);
#pragma unroll
                for (int dt = 0; dt < 2; ++dt) {
                    const int ch = h * 64 + (2 * dh + dt) * 16 + 4 * fq;
                    const u32x2 uv = uvv[pt][dt], gv = gvs[pt][dt];
                    u32x2 w; w.x = pk2((acc[dt][pt][0] + bsv) * bf_lo(uv.x) * bf_lo(gv.x), (acc[dt][pt][1] + bsv) * bf_hi(uv.x) * bf_hi(gv.x));
                    w.y = pk2((acc[dt][pt][2] + bsv) * bf_lo(uv.y) * bf_lo(gv.y), (acc[dt][pt][3] + bsv) * bf_hi(uv.y) * bf_hi(gv.y));
                    *(u32x2*)(Y + tok * DM + 768 + ch) = w;
                }
            }
        }
    }
}

__device__ __forceinline__ void final_phase(float* out, const float* ssq, const float* fg) {
    const int tid = threadIdx.x, lane = tid & 63, wave = tid >> 6;
    const int gw = blockIdx.x * NWAVES + wave, NGW = gridDim.x * NWAVES;
    f32x4 g[4];
#pragma unroll
    for (int j = 0; j < 4; ++j) g[j] = *((const f32x4*)fg + lane + 64 * j);
    for (int m = gw; m < M; m += NGW) {
        const f32x4* sp = (const f32x4*)(ssq + (size_t)m * 16);
        const f32x4 st = (sp[0] + sp[1]) + (sp[2] + sp[3]);
        const float rs = __builtin_amdgcn_rsqf(((st[0] + st[1]) + (st[2] + st[3])) * (1.0f / 1024.0f) + 1e-6f);
        f32x4* xr = (f32x4*)(out + (size_t)m * DM) + lane;
        f32x4 v[4];
#pragma unroll
        for (int j = 0; j < 4; ++j) v[j] = xr[64 * j];
#pragma unroll
        for (int j = 0; j < 4; ++j) xr[64 * j] = v[j] * rs * g[j];
    }
}

__global__ void __launch_bounds__(NT, 2) fwd_megakernel(Args a) {
    extern __shared__ __attribute__((aligned(16))) unsigned char lds_raw[];
    LAS unsigned char* lds = (LAS unsigned char*)lds_raw;
    cg::grid_group grid = cg::this_grid();
    volatile LAS unsigned* bst = (volatile LAS unsigned*)(lds + BAR_LDS_OFF);
    if (threadIdx.x < 2) bst[threadIdx.x] = 0u;
    __syncthreads();
    XcdBarrier bar = xcd_barrier_post((unsigned*)a.ws, bst);
    unsigned char* ws = a.ws;
    const int lo = a.ph_lo, hi = a.ph_hi;
#define IN(k) (lo <= (k) && (k) < hi)
#define SEAM(k) do { if (IN(k) && IN((k) + 1)) { if (USE_CG_SYNC && (k) == 0) grid.sync(); else xcd_barrier(bar); } } while (0)
    bf16_t* XB = (bf16_t*)(ws + WS_XB); bf16_t* Zp = (bf16_t*)(ws + WS_Z); bf16_t* VT = (bf16_t*)(ws + WS_VT); bf16_t* Yp = (bf16_t*)(ws + WS_Y); float* ssq = (float*)(ws + WS_SSQ);
    if ((PHMASK & 1) && IN(0)) { for (int rep = 0; rep < PROREP; ++rep) { prologue(lds, a); __syncthreads(); } }
    SEAM(0);
    for (int l = 0; l < DEPTH; ++l) {
        const int p0 = 1 + 3 * l;
        if ((PHMASK & 2) && IN(p0)) {
            pg8::Gemm g{XB, (const bf16_t*)(ws + WS_WIN) + (size_t)l * DIN * DM, M, DIN, DM}; pg8::StaticOrder S; S.init(M, DIN, (int)gridDim.x, (int)blockIdx.x);
            pg8::EpiZ E{Zp, VT, ssq};
            for (int rep = 0; rep < G1REP; ++rep) pg8::gemm_phase<pg8::EpiZ, pg8::StaticOrder, true, true>(lds, g, S, E);
        }
        SEAM(p0);
        if ((PHMASK & 4) && IN(p0 + 1)) {
            MixW W;
            W.rpb = a.in[3] + (size_t)l * 8 * 465; W.dw_w = a.in[4] + (size_t)l * 31 * 256; W.dw_b = a.in[5] + l * 256; W.cln_g = a.in[6] + l * 256; W.cln_b = a.in[7] + l * 256;
            W.sln_g = a.in[11] + l * 256; W.sln_b = a.in[12] + l * 256; W.sgu_b = a.in[14] + l * 512;
            W.PWT = (const bf16_t*)(ws + WS_PW) + (size_t)l * 65536; W.POOLT = (const bf16_t*)(ws + WS_POOL) + (size_t)l * 16384; W.SGW = (const bf16_t*)(ws + WS_SGW) + (size_t)l * 65536;
            for (int rep = 0; rep < MIXREP; ++rep) mixer_phase(lds, Zp, VT, Yp, W);
            __syncthreads();
        }
        SEAM(p0 + 1);
        if ((PHMASK & 8) && IN(p0 + 2)) {
            pg8::Gemm g{Yp, (const bf16_t*)(ws + WS_WOUT) + (size_t)l * DM * DM, M, DM, DM}; pg8::StaticOrder S; S.init(M, DM, (int)gridDim.x, (int)blockIdx.x);
            pg8::EpiX E{l == 0 ? a.in[0] : a.out, a.out, XB, ssq, l + 1 < DEPTH ? 1 : 0};
            for (int rep = 0; rep < (l == 0 ? G2REP : 1); ++rep) pg8::gemm_phase<pg8::EpiX, pg8::StaticOrder, true, true>(lds, g, S, E);
        }
        SEAM(p0 + 2);
    }
    if ((PHMASK & 16) && IN(7)) final_phase(a.out, ssq, a.in[16]);
#undef IN
#undef SEAM
}

extern "C" void kernel_launch(void* const* d_in, const int* in_sizes, int n_in, void* d_out, int out_size, void* d_ws, size_t ws_size, hipStream_t stream) {
    static int grid = 0;
    if (grid == 0) {
        if (n_in != 17 || in_sizes[0] != M * DM || out_size != M * DM || ws_size < WS_END) { fprintf(stderr, "kernel_launch: unexpected shapes (n_in %d, in0 %d, out %d, ws %zu)\n", n_in, n_in > 0 ? in_sizes[0] : -1, out_size, ws_size); grid = -1; return; }
        int dev = 0, cus = 0, per_cu = 0;
        if (hipGetDevice(&dev) != hipSuccess || hipDeviceGetAttribute(&cus, hipDeviceAttributeMultiprocessorCount, dev) != hipSuccess) { grid = -1; return; }
        if (hipFuncSetAttribute((const void*)fwd_megakernel, hipFuncAttributeMaxDynamicSharedMemorySize, LDS_BYTES) != hipSuccess) { fprintf(stderr, "kernel_launch: hipFuncSetAttribute failed\n"); grid = -1; return; }
        if (hipOccupancyMaxActiveBlocksPerMultiprocessor(&per_cu, (const void*)fwd_megakernel, NT, LDS_BYTES) != hipSuccess || per_cu < 1) { fprintf(stderr, "kernel_launch: occupancy query gave %d\n", per_cu); per_cu = 1; }
        (void)hipGetLastError();
        grid = cus * per_cu;
    }
    if (grid < 0) return;
    Args a{};
    for (int i = 0; i < 17; ++i) a.in[i] = (const float*)d_in[i];
    a.out = (float*)d_out; a.ws = (unsigned char*)d_ws;
    if (MK_N_LAUNCHES == 1) {
        a.ph_lo = 0; a.ph_hi = 8;
        if (hipMemsetAsync(d_ws, 0, 16384, stream) != hipSuccess) { fprintf(stderr, "kernel_launch: memset of the barrier words failed\n"); return; }
        void* args[] = {&a};
        hipError_t e = hipLaunchCooperativeKernel((const void*)fwd_megakernel, dim3(grid), dim3(NT), args, LDS_BYTES, stream);
        if (e != hipSuccess) fprintf(stderr, "cooperative launch failed: %s (grid %d)\n", hipGetErrorString(e), grid);
    } else {
        for (int p = 0; p < 8; ++p) {
            a.ph_lo = p; a.ph_hi = p + 1;
            hipLaunchKernelGGL(fwd_megakernel, dim3(grid), dim3(NT), LDS_BYTES, stream, a);
        }
    }
}
```

```cpp
#include <hip/hip_runtime.h>
#include <hip/hip_cooperative_groups.h>
#include <cstdio>
#include <cstdint>
namespace cg = cooperative_groups;
#ifndef MK_N_LAUNCHES
#define MK_N_LAUNCHES 1
#endif
typedef float f32x2 __attribute__((ext_vector_type(2)));
typedef unsigned u32x2 __attribute__((ext_vector_type(2)));
__device__ __forceinline__ unsigned pk2(float lo, float hi) {
    typedef __bf16 bf2 __attribute__((ext_vector_type(2)));
    bf2 v = __builtin_convertvector((f32x2){lo, hi}, bf2);
    return __builtin_bit_cast(unsigned, v);
}
__device__ __forceinline__ unsigned short bf1(float x) { __bf16 v = (__bf16)x; return __builtin_bit_cast(unsigned short, v); }
__device__ __forceinline__ float bf_lo(unsigned u) { return __uint_as_float(u << 16); }
__device__ __forceinline__ float bf_hi(unsigned u) { return __uint_as_float(u & 0xffff0000u); }
__device__ __forceinline__ float fexp(float x) { return __builtin_amdgcn_exp2f(x * 1.44269504f); }
__device__ __forceinline__ float frcp(float x) { return __builtin_amdgcn_rcpf(x); }
__device__ __forceinline__ float silu_f(float x) { return x * frcp(1.f + fexp(-x)); }
__device__ __forceinline__ float gelu_f(float x) { const float u = 0.7978845608f * (x + 0.044715f * x * x * x); return x * frcp(1.f + fexp(-2.f * u)); }
__device__ __forceinline__ float wave_sum(float v) {
#pragma unroll
    for (int o = 1; o < 64; o <<= 1) v += __shfl_xor(v, o);
    return v;
}
namespace pg8 {
#define PG8_LAS __attribute__((address_space(3)))
typedef unsigned short bf16_t;
typedef short bf16x8 __attribute__((ext_vector_type(8)));
typedef float f32x4 __attribute__((ext_vector_type(4)));
typedef unsigned u32x4 __attribute__((ext_vector_type(4)));
constexpr int BM = 256, BK = 64, HALF = 128, HTB = HALF * BK * 2  , STAGE_BYTES = 8 * HTB, NXCD = 8, WGM = 8;

__host__ __device__ __forceinline__ int lds_byte(int r, int c) { const int st = (r >> 4) * 2 + (c >> 5), rr = r & 15, cc = c & 31, ob = rr * 64 + cc * 2; return st * 1024 + (ob ^ (((ob >> 9) & 1) << 5)); }
__host__ __device__ __forceinline__ void stage_rc(int b, int& R, int& C) { const int st = b / 1024, sb = b % 1024, swz = sb ^ (((sb >> 9) & 1) << 5); R = (st >> 1) * 16 + swz / 64; C = (st & 1) * 32 + (swz % 64) / 2; }
__host__ __device__ __forceinline__ int perm32(int rho) { const int n = rho >> 4, i = rho & 15; return 8 * (i >> 2) + 4 * n + (i & 3); }

struct Unit { int pm, pn; };
struct Gemm { const bf16_t* A; const bf16_t* Bt; int M, N, K; };

struct StaticOrder {
    int nM, nN, nwg, G, c;
    __host__ __device__ void init(int M, int N, int G_, int c_) { nM = M / BM; nN = N / BM; nwg = nM * nN; G = G_; c = c_; }
    __host__ __device__ bool next(int i, Unit& u) const {
        const long L = (long)i * G + c; if (L >= nwg) return false;
        int wgid = (int)L; { const int q = nwg / NXCD, r = nwg % NXCD, xcd = wgid % NXCD, off = wgid / NXCD; wgid = (xcd < r ? xcd * (q + 1) : r * (q + 1) + (xcd - r) * q) + off; }
        const int nig = WGM * nN, gid = wgid / nig, fm = gid * WGM, gsz = (nM - fm) < WGM ? (nM - fm) : WGM;
        u.pm = fm + ((wgid % nig) % gsz); u.pn = (wgid % nig) / gsz; return true;
    }
    __device__ __forceinline__ void a_ready(const Unit&) const {}
    __device__ __forceinline__ void done(const Unit&) const {}
};
struct EpiZ {
    static constexpr bool PERM = true, AFTER_DRAIN = false;
    bf16_t* Z; bf16_t* VT; const float* ssq;
    __device__ __forceinline__ void operator()(const f32x4 (&acc)[2][2][4][2], const Unit& u, int wr, int wc, int fr, int fq) const {
        const int row0 = u.pm * BM + wr * 64 + fr, pn = u.pn, col0 = pn * BM + wc * 32 + 8 * fq;
        const int act = (pn >= 8) ? 2 : (pn >= 6 ? 1 : 0);
#pragma unroll
        for (int ai = 0; ai < 2; ++ai)
#pragma unroll
            for (int m = 0; m < 4; ++m) {
                const int row = row0 + ai * HALF + m * 16;
                const f32x4* sp = (const f32x4*)(ssq + (size_t)row * 16);
                const f32x4 st = (sp[0] + sp[1]) + (sp[2] + sp[3]);
                const float rs = __builtin_amdgcn_rsqf(((st[0] + st[1]) + (st[2] + st[3])) * (1.0f / 1024.0f) + 1e-6f);
#pragma unroll
                for (int bj = 0; bj < 2; ++bj) {
                    f32x4 v0 = acc[ai][bj][m][0] * rs, v1 = acc[ai][bj][m][1] * rs;
                    if (act == 1) {
#pragma unroll
                        for (int e = 0; e < 4; ++e) { v0[e] = gelu_f(v0[e]); v1[e] = gelu_f(v1[e]); }
                    } else if (act == 2) {
#pragma unroll
                        for (int e = 0; e < 4; ++e) { v0[e] = silu_f(v0[e]); v1[e] = silu_f(v1[e]); }
                    }
                    if (pn == 2) {
                        const int b = row >> 11, s = row & 2047, h = 4 * bj + wc;
                        bf16_t* vp = VT + ((size_t)((b * 8 + h) * 32 + 8 * fq)) * 2048 + s;
#pragma unroll
                        for (int e = 0; e < 4; ++e) { vp[(size_t)e * 2048] = bf1(v0[e]); vp[(size_t)(4 + e) * 2048] = bf1(v1[e]); }
                    } else {
                        u32x4 w; w.x = pk2(v0[0], v0[1]); w.y = pk2(v0[2], v0[3]); w.z = pk2(v1[0], v1[1]); w.w = pk2(v1[2], v1[3]);
                        *(u32x4*)(Z + (size_t)row * 3072 + col0 + bj * HALF) = w;
                    }
                }
            }
    }
};
struct EpiX {
    static constexpr bool PERM = false, AFTER_DRAIN = false;
    const float* xin; float* xout; bf16_t* xb; float* ssq; int write_xb;
    __device__ __forceinline__ void operator()(const f32x4 (&acc)[2][2][4][2], const Unit& u, int wr, int wc, int fr, int fq) const {
        const int row0 = u.pm * BM + wr * 64 + fr, col0 = u.pn * BM + wc * 32 + 4 * fq;
#pragma unroll
        for (int ai = 0; ai < 2; ++ai)
#pragma unroll
            for (int m = 0; m < 4; ++m) {
                const int row = row0 + ai * HALF + m * 16; const size_t off = (size_t)row * 1024 + col0;
                float q = 0.f;
#pragma unroll
                for (int bj = 0; bj < 2; ++bj)
#pragma unroll
                    for (int n = 0; n < 2; ++n) {
                        const f32x4 xv = *(const f32x4*)(xin + off + bj * HALF + n * 16);
                        const f32x4 o = xv + acc[ai][bj][m][n];
                        *(f32x4*)(xout + off + bj * HALF + n * 16) = o;
                        q += (o[0] * o[0] + o[1] * o[1]) + (o[2] * o[2] + o[3] * o[3]);
                        if (write_xb) { u32x2 w; w.x = pk2(o[0], o[1]); w.y = pk2(o[2], o[3]); *(u32x2*)(xb + off + bj * HALF + n * 16) = w; }
                    }
                q += __shfl_xor(q, 16); q += __shfl_xor(q, 32);
                if (fq == 0) ssq[(size_t)row * 16 + u.pn * 4 + wc] = q;
            }
    }
};
template <class Epi, class Sched, bool ALIGN_EPI = false, bool SP2 = false>
__device__ __forceinline__ void gemm_phase(PG8_LAS unsigned char* lds, const Gemm g, const Sched& S, const Epi& E) {
    int tid_ = threadIdx.x; asm volatile("" : "+v"(tid_));
    const int tid = tid_, wid = __builtin_amdgcn_readfirstlane(tid >> 6), lane = tid & 63, wr = wid >> 2, wc = wid & 3, fr = lane & 15, fq = lane >> 4;
    const int K = g.K, nt = K / BK;
    unsigned voffA[2], voffB[2];
#pragma unroll
    for (int i = 0; i < 2; ++i) { int R, C; stage_rc(tid * 16 + i * 8192, R, C); const int Rb = Epi::PERM ? ((R & ~31) + perm32(R & 31)) : R;
        voffA[i] = (unsigned)(R * K + C) * 2u; voffB[i] = (unsigned)(Rb * K + C) * 2u; }
    const size_t kstep = (size_t)(BK * 2);
    const size_t hstep = (size_t)HALF * K * 2;
    const size_t tstep = 2 * hstep;
    const unsigned ldsw = (unsigned)wid * 1024u;
    const int aoff = lds_byte(wr * 64 + fr, fq * 8), boff = lds_byte(wc * 32 + fr, fq * 8);
#define PG8_SA(b, h) (((b) * 2 + (h)) * HTB)
#define PG8_SB(b, h) ((4 + (b) * 2 + (h)) * HTB)
#define PG8_STAGE(bufoff, gbase, voff) do { _Pragma("unroll") for (int _i = 0; _i < 2; ++_i) \
        __builtin_amdgcn_global_load_lds((const unsigned*)((const char*)(gbase) + (voff)[_i]), (PG8_LAS unsigned*)(lds + (bufoff) + ldsw + _i * 8192), 16, 0, 0); } while (0)
#define PG8_LDA(dst, b, h) do { _Pragma("unroll") for (int m = 0; m < 4; ++m) _Pragma("unroll") for (int k = 0; k < 2; ++k) dst[m][k] = *(const PG8_LAS bf16x8*)(lds + PG8_SA(b, h) + aoff + m * 2048 + k * 1024); } while (0)
#define PG8_LDB(dst, b, h) do { _Pragma("unroll") for (int n = 0; n < 2; ++n) _Pragma("unroll") for (int k = 0; k < 2; ++k) dst[n][k] = *(const PG8_LAS bf16x8*)(lds + PG8_SB(b, h) + boff + n * 2048 + k * 1024); } while (0)
#define PG8_MMA(ai, bj, At, Bt) do { __builtin_amdgcn_s_setprio(1); _Pragma("unroll") for (int m = 0; m < 4; ++m) _Pragma("unroll") for (int n = 0; n < 2; ++n) _Pragma("unroll") for (int k = 0; k < 2; ++k) \
        acc[ai][bj][m][n] = __builtin_amdgcn_mfma_f32_16x16x32_bf16(Bt[n][k], At[m][k], acc[ai][bj][m][n], 0, 0, 0); __builtin_amdgcn_s_setprio(0); } while (0)
#define PG8_WAIT_V(n) asm volatile("s_waitcnt vmcnt(" #n ")" ::: "memory")
#define PG8_WAIT_L(n) asm volatile("s_waitcnt lgkmcnt(" #n ")" ::: "memory")
#define PG8_BAR __builtin_amdgcn_s_barrier()
#define PG8_SCHED __builtin_amdgcn_sched_barrier(0)
    Unit cur, nxt; int ui = 0;
    if (!S.next(0, cur)) return;
    f32x4 acc[2][2][4][2];
#pragma unroll
    for (int a = 0; a < 2; ++a)
#pragma unroll
        for (int b = 0; b < 2; ++b)
#pragma unroll
            for (int m = 0; m < 4; ++m)
#pragma unroll
                for (int n = 0; n < 2; ++n) acc[a][b][m][n] = (f32x4){0.f, 0.f, 0.f, 0.f};
    bf16x8 At[4][2], B0[2][2], B1[2][2];
    const char* cA = (const char*)g.A + (size_t)cur.pm * tstep; const char* cB = (const char*)g.Bt + (size_t)cur.pn * tstep;
    S.a_ready(cur);
    if constexpr (SP2) {
        PG8_STAGE(PG8_SB(0, 0), cB, voffB); PG8_STAGE(PG8_SB(0, 1), cB + hstep, voffB); PG8_STAGE(PG8_SA(0, 0), cA, voffA); PG8_STAGE(PG8_SA(0, 1), cA + hstep, voffA);
        if (wr == 1) PG8_BAR;
        PG8_WAIT_V(2); PG8_BAR;
        PG8_STAGE(PG8_SB(1, 0), cB + kstep, voffB); PG8_STAGE(PG8_SA(1, 0), cA + kstep, voffA); PG8_STAGE(PG8_SB(1, 1), cB + hstep + kstep, voffB);
        PG8_WAIT_V(6); PG8_BAR;
    } else {
        PG8_STAGE(PG8_SB(0, 0), cB, voffB); PG8_STAGE(PG8_SA(0, 0), cA, voffA); PG8_STAGE(PG8_SB(0, 1), cB + hstep, voffB); PG8_STAGE(PG8_SA(0, 1), cA + hstep, voffA);
        if (wr == 1) PG8_BAR;
        PG8_WAIT_V(4); PG8_BAR;
        PG8_STAGE(PG8_SB(1, 0), cB + kstep, voffB); PG8_STAGE(PG8_SA(1, 0), cA + kstep, voffA); PG8_STAGE(PG8_SB(1, 1), cB + hstep + kstep, voffB);
        PG8_WAIT_V(6); PG8_BAR;
    }
    for (;;) {
        const bool has_next = S.next(ui + 1, nxt);
        const char* nA = has_next ? (const char*)g.A + (size_t)nxt.pm * tstep : cA; const char* nB = has_next ? (const char*)g.Bt + (size_t)nxt.pn * tstep : cB;
        for (int t = 0; t < nt; t += 2) {
            const bool last = (t == nt - 2);
            const char* a1 = cA + (size_t)(t + 1) * kstep;
            const char* a2 = last ? nA : cA + (size_t)(t + 2) * kstep; const char* b2 = last ? nB : cB + (size_t)(t + 2) * kstep;
            const char* a3 = a2 + kstep; const char* b3 = b2 + kstep;
            if (last && has_next) S.a_ready(nxt);
            if constexpr (SP2) {
            PG8_LDB(B0, 0, 0); PG8_LDB(B1, 0, 1); PG8_SCHED; PG8_LDA(At, 0, 0); PG8_STAGE(PG8_SA(1, 1), a1 + hstep, voffA);
            PG8_WAIT_V(8); PG8_WAIT_L(0); PG8_BAR; PG8_MMA(0, 0, At, B0); PG8_MMA(0, 1, At, B1); PG8_BAR; PG8_SCHED;
            PG8_LDA(At, 0, 1); PG8_STAGE(PG8_SB(0, 0), b2, voffB); PG8_STAGE(PG8_SB(0, 1), b2 + hstep, voffB); PG8_STAGE(PG8_SA(0, 0), a2, voffA);
            PG8_WAIT_V(8); PG8_WAIT_L(0); PG8_BAR; PG8_MMA(1, 0, At, B0); PG8_MMA(1, 1, At, B1); PG8_BAR; PG8_SCHED;
            PG8_LDB(B0, 1, 0); PG8_LDB(B1, 1, 1); PG8_SCHED; PG8_LDA(At, 1, 0); PG8_STAGE(PG8_SA(0, 1), a2 + hstep, voffA);
            PG8_WAIT_V(8); PG8_WAIT_L(0); PG8_BAR; PG8_MMA(0, 0, At, B0); PG8_MMA(0, 1, At, B1); PG8_BAR; PG8_SCHED;
            PG8_LDA(At, 1, 1); PG8_STAGE(PG8_SB(1, 0), b3, voffB); PG8_STAGE(PG8_SB(1, 1), b3 + hstep, voffB); PG8_STAGE(PG8_SA(1, 0), a3, voffA);
            PG8_WAIT_V(8); PG8_WAIT_L(0); PG8_BAR; PG8_MMA(1, 0, At, B0); PG8_MMA(1, 1, At, B1); PG8_BAR; PG8_SCHED;
            } else {
            PG8_LDB(B0, 0, 0); PG8_SCHED; PG8_LDA(At, 0, 0); PG8_STAGE(PG8_SA(1, 1), a1 + hstep, voffA);
            PG8_WAIT_L(8); PG8_BAR; PG8_WAIT_L(0); PG8_MMA(0, 0, At, B0); PG8_BAR; PG8_SCHED;
            PG8_LDB(B1, 0, 1); PG8_STAGE(PG8_SB(0, 0), b2, voffB);
            PG8_BAR; PG8_WAIT_L(0); PG8_MMA(0, 1, At, B1); PG8_BAR;
            PG8_LDA(At, 0, 1); PG8_STAGE(PG8_SA(0, 0), a2, voffA);
            PG8_BAR; PG8_WAIT_L(0); PG8_MMA(1, 0, At, B0); PG8_BAR; PG8_SCHED;
            PG8_STAGE(PG8_SB(0, 1), b2 + hstep, voffB);
            PG8_WAIT_V(6); PG8_BAR; PG8_MMA(1, 1, At, B1); PG8_BAR;
            PG8_LDB(B0, 1, 0); PG8_SCHED; PG8_LDA(At, 1, 0); PG8_STAGE(PG8_SA(0, 1), a2 + hstep, voffA);
            PG8_WAIT_L(8); PG8_BAR; PG8_WAIT_L(0); PG8_MMA(0, 0, At, B0); PG8_BAR; PG8_SCHED;
            PG8_LDB(B1, 1, 1); PG8_STAGE(PG8_SB(1, 0), b3, voffB);
            PG8_BAR; PG8_WAIT_L(0); PG8_MMA(0, 1, At, B1); PG8_BAR;
            PG8_LDA(At, 1, 1); PG8_STAGE(PG8_SA(1, 0), a3, voffA);
            PG8_BAR; PG8_WAIT_L(0); PG8_MMA(1, 0, At, B0); PG8_BAR; PG8_SCHED;
            PG8_STAGE(PG8_SB(1, 1), b3 + hstep, voffB);
            PG8_WAIT_V(6); PG8_BAR; PG8_MMA(1, 1, At, B1); PG8_BAR;
            }
        }
        if constexpr (ALIGN_EPI) { if (wr == 0) PG8_BAR; }
        if constexpr (!Epi::AFTER_DRAIN) { E(acc, cur, wr, wc, fr, fq); S.done(cur); }
        if (!has_next) break;
#pragma unroll
        for (int a = 0; a < 2; ++a)
#pragma unroll
            for (int b = 0; b < 2; ++b)
#pragma unroll
                for (int m = 0; m < 4; ++m)
#pragma unroll
                    for (int n = 0; n < 2; ++n) acc[a][b][m][n] = (f32x4){0.f, 0.f, 0.f, 0.f};
        cur = nxt; cA = nA; cB = nB; ++ui;
        if constexpr (ALIGN_EPI) { if (wr == 1) PG8_BAR; }
    }
    PG8_WAIT_V(0);
    if constexpr (!ALIGN_EPI) { if (wr == 0) PG8_BAR; }
    PG8_BAR;
    if constexpr (Epi::AFTER_DRAIN) { E.fused(acc, cur, wr, wc, fr, fq, lds, wid, lane); S.done(cur); }
#undef PG8_SA
#undef PG8_SB
#undef PG8_STAGE
#undef PG8_LDA
#undef PG8_LDB
#undef PG8_MMA
#undef PG8_WAIT_V
#undef PG8_WAIT_L
#undef PG8_BAR
#undef PG8_SCHED
}
}

#define LAS __attribute__((address_space(3)))
typedef unsigned short bf16_t;
typedef short bf16x8 __attribute__((ext_vector_type(8)));
typedef float f32x4 __attribute__((ext_vector_type(4)));
typedef unsigned u32x4 __attribute__((ext_vector_type(4)));
constexpr int NWAVES = 8, NT = NWAVES * 64;
constexpr int M = 16384, DM = 1024, DIN = 3072, SEQ = 2048, DEPTH = 2;
constexpr size_t MiB = 1u << 20;
constexpr size_t WS_WIN = 2 * MiB, WS_WOUT = 14 * MiB, WS_PW = 18 * MiB, WS_POOL = 18 * MiB + 256 * 1024, WS_SGW = 18 * MiB + 512 * 1024;
constexpr size_t WS_SSQ = 19 * MiB, WS_XB = 20 * MiB, WS_Y = 52 * MiB, WS_VT = 84 * MiB, WS_Z = 92 * MiB, WS_END = 188 * MiB;
constexpr int LDS_BYTES = 147456, RPB_OFF = 131072, BAR_LDS_OFF = 146432;
constexpr int L_R0 = 0, L_R1 = 49920, L_R2 = 91904, L_STAT = 129024, ROWB = 528  , VNT_ROWB = 272;
#define MFMA16(a, b, c) __builtin_amdgcn_mfma_f32_16x16x32_bf16((a), (b), (c), 0, 0, 0)
#define LDS_WAIT() asm volatile("s_waitcnt lgkmcnt(0)" ::: "memory")
#define LBAR() do { asm volatile("s_waitcnt lgkmcnt(0)" ::: "memory"); __builtin_amdgcn_s_barrier(); asm volatile("" ::: "memory"); } while (0)

#ifndef G2REP
#define G2REP 1
#endif
#ifndef G1REP
#define G1REP 1
#endif
#ifndef PROREP
#define PROREP 1
#endif
#ifndef USE_CG_SYNC
#define USE_CG_SYNC 0
#endif
#ifndef NA_PROBE_VAR
#define NA_PROBE_VAR 0
#endif
#ifndef REP_NA
#define REP_NA 1
#endif
#ifndef REP_CONV
#define REP_CONV 1
#endif
#ifndef REP_POOL
#define REP_POOL 1
#endif
#ifndef REP_SGU
#define REP_SGU 1
#endif
#ifndef NA_UNROLL
#define NA_UNROLL 4
#endif
#ifndef MIXREP
#define MIXREP 1
#endif
#ifndef MIXMASK
#define MIXMASK 15
#endif
#ifndef PHMASK
#define PHMASK 31
#endif
struct Args { const float* in[17]; float* out; unsigned char* ws; int ph_lo, ph_hi; };

#define XB_TMO      128
#define XB_XCNT(j)  (256  + 64 * (j))
#define XB_XSUB(j)  (1280 + 64 * (j))
#define XB_XGEN(j)  (2304 + 64 * (j))
#define XB_TOP      3328
#define XB_TOPGEN   3392
#define XCD_BAR_WORDS 3456
#define XB_SPIN_CAP (1u << 18)

__device__ __forceinline__ unsigned xb_ld(unsigned* p)              { return __hip_atomic_load(p, __ATOMIC_RELAXED, __HIP_MEMORY_SCOPE_AGENT); }
__device__ __forceinline__ unsigned xb_add(unsigned* p, unsigned v) { return __hip_atomic_fetch_add(p, v, __ATOMIC_RELAXED, __HIP_MEMORY_SCOPE_AGENT); }
__device__ __forceinline__ unsigned xb_xcc_id() { return (unsigned)__builtin_amdgcn_s_getreg((3 << 11) | 20) & 0xFu; }
#define XB_SPIN(cond, bar) do { unsigned _sp = 0; while (cond) { __builtin_amdgcn_s_sleep(1); \
    if ((++_sp & 255u) == 0u) { if (xb_ld(&(bar)[XB_TMO])) break; if (_sp > XB_SPIN_CAP) { atomicAdd(&(bar)[XB_TMO], 1u); break; } } } } while (0)

struct XcdBarrier {
    unsigned* bar; unsigned x;
    volatile LAS unsigned* st;
};

__device__ __forceinline__ XcdBarrier xcd_barrier_post(unsigned* bar, volatile LAS unsigned* st) {
    XcdBarrier b; b.bar = bar; b.x = xb_xcc_id(); b.st = st;
    if (threadIdx.x == 0) (void)xb_add(&bar[XB_XCNT(b.x)], 1u);
    return b;
}
__device__ __forceinline__ void xcd_barrier_complete(unsigned* bar, unsigned x, unsigned& nloc, unsigned& nx) {
    const unsigned G = gridDim.x * gridDim.y * gridDim.z;
    unsigned sum, cnt, mine, sp = 0u;
    for (;;) {
        sum = 0u; cnt = 0u; mine = 0u;
#pragma unroll
        for (unsigned j = 0; j < 16; ++j) { const unsigned c = xb_ld(&bar[XB_XCNT(j)]); sum += c; cnt += (c > 0u) ? 1u : 0u; mine = (j == x) ? c : mine; }
        if (sum == G) break;
        __builtin_amdgcn_s_sleep(1);
        if ((++sp & 255u) == 0u) { if (xb_ld(&bar[XB_TMO])) break; if (sp > XB_SPIN_CAP) { atomicAdd(&bar[XB_TMO], 1u); break; } }
    }
    nloc = mine > 0u ? mine : 1u; nx = cnt > 0u ? cnt : 1u;
}

__device__ __forceinline__ void xcd_barrier(const XcdBarrier& b) {
    asm volatile("s_waitcnt vmcnt(0)" ::: "memory");
    __syncthreads();
    if (threadIdx.x == 0) {
        unsigned* bar = b.bar;
        __builtin_amdgcn_s_waitcnt(0);
        unsigned nloc = b.st[0], nx = b.st[1];
        if (nloc == 0u) { xcd_barrier_complete(bar, b.x, nloc, nx); b.st[0] = nloc; b.st[1] = nx; }
        const unsigned old = xb_add(&bar[XB_XSUB(b.x)], 1u);
        const unsigned gen = old / nloc;
        if (old + 1u == (gen + 1u) * nloc) {
            __builtin_amdgcn_fence(__ATOMIC_RELEASE, "agent");
            asm volatile("s_waitcnt vmcnt(0)" ::: "memory");
            const unsigned og = xb_add(&bar[XB_TOP], 1u);
            const unsigned tg = og / nx;
            if (og + 1u == (tg + 1u) * nx) xb_add(&bar[XB_TOPGEN], 1u);
            else XB_SPIN(xb_ld(&bar[XB_TOPGEN]) == tg, bar);
            __builtin_amdgcn_fence(__ATOMIC_ACQUIRE, "agent");
            xb_add(&bar[XB_XGEN(b.x)], 1u);
            asm volatile("s_waitcnt vmcnt(0)" ::: "memory");
        } else {
            XB_SPIN(xb_ld(&bar[XB_XGEN(b.x)]) == gen, bar);
            __builtin_amdgcn_fence(__ATOMIC_ACQUIRE, "agent");
            asm volatile("s_waitcnt vmcnt(0)" ::: "memory");
        }
    }
    __syncthreads();
}

__device__ __forceinline__ void transpose_item(const float* W, int K, int N, bf16_t* WT, LAS float* scr, int item, int lane, const float* ks, const float* ns, int qcols) {
    const int nblk = N / 32, kb = item / nblk, nb = item % nblk, k0 = 64 * kb, n0 = 32 * nb, n = n0 + (lane & 31);
    float nsv = ns ? ns[n] : 1.f; if (n < qcols) nsv *= 0.17677669529663687f;
#pragma unroll 8
    for (int i = 0; i < 32; ++i) { const int kk = 2 * i + (lane >> 5); const float kv = ks ? ks[k0 + kk] : 1.f; scr[kk * 33 + (lane & 31)] = W[(size_t)(k0 + kk) * N + n] * (kv * nsv); }
    LDS_WAIT(); asm volatile("" ::: "memory");
    const int c = lane & 7;
#pragma unroll
    for (int j = 0; j < 4; ++j) { const int nn = (lane >> 3) + 8 * j; const LAS float* s = scr + (8 * c) * 33 + nn;
        u32x4 o; o.x = pk2(s[0 * 33], s[1 * 33]); o.y = pk2(s[2 * 33], s[3 * 33]); o.z = pk2(s[4 * 33], s[5 * 33]); o.w = pk2(s[6 * 33], s[7 * 33]);
        *(u32x4*)(WT + (size_t)(n0 + nn) * K + k0 + 8 * c) = o; }
    LDS_WAIT(); asm volatile("" ::: "memory");
}
__device__ __forceinline__ void prologue(LAS unsigned char* lds, const Args& a) {
    const int tid = threadIdx.x, lane = tid & 63, wave = __builtin_amdgcn_readfirstlane(tid >> 6);
    LAS float* scr = (LAS float*)(lds + wave * 16384);
    const int gw = blockIdx.x * NWAVES + wave, NGW = gridDim.x * NWAVES;
    unsigned char* ws = a.ws;
    constexpr int I_IN = 16 * 96, I_OUT = 16 * 32, I_PW = 4 * 8, I_PL = 2, PER_L = I_IN + I_OUT + I_PW + 4 * I_PL;
    for (int it = gw; it < DEPTH * PER_L; it += NGW) {
        const int l = it / PER_L; int r = it % PER_L;
        if (r < I_IN) { transpose_item(a.in[2] + (size_t)l * DM * DIN, DM, DIN, (bf16_t*)(ws + WS_WIN) + (size_t)l * DIN * DM, scr, r, lane, a.in[1] + l * DM, nullptr, 256); continue; } r -= I_IN;
        if (r < I_OUT) { transpose_item(a.in[15] + (size_t)l * DM * DM, DM, DM, (bf16_t*)(ws + WS_WOUT) + (size_t)l * DM * DM, scr, r, lane, nullptr, nullptr, 0); continue; } r -= I_OUT;
        if (r < I_PW) { transpose_item(a.in[8] + (size_t)l * 65536, 256, 256, (bf16_t*)(ws + WS_PW) + (size_t)l * 65536, scr, r, lane, nullptr, nullptr, 0); continue; } r -= I_PW;
        { const int g = r / I_PL, i = r % I_PL;
          transpose_item(a.in[9] + (size_t)(l * 4 + g) * 4096, 64, 64, (bf16_t*)(ws + WS_POOL) + (size_t)(l * 4 + g) * 4096, scr, i, lane, nullptr, a.in[10] + l * 256 + g * 64, 0); }
    }
    { const float* src = a.in[13]; bf16_t* dst = (bf16_t*)(ws + WS_SGW);
      for (int i = (blockIdx.x * NT + tid) * 4; i < DEPTH * 65536; i += gridDim.x * NT * 4) { const f32x4 v = *(const f32x4*)(src + i); u32x2 w; w.x = pk2(v[0], v[1]); w.y = pk2(v[2], v[3]); *(u32x2*)(dst + i) = w; } }
    { const float* x = a.in[0]; bf16_t* xb = (bf16_t*)(ws + WS_XB); float* ssq = (float*)(ws + WS_SSQ);
      for (int m = gw; m < M; m += NGW) {
          const f32x4* xr = (const f32x4*)(x + (size_t)m * DM) + lane; f32x4 v[4]; float s = 0.f;
#pragma unroll
          for (int j = 0; j < 4; ++j) { v[j] = xr[64 * j]; s += (v[j][0] * v[j][0] + v[j][1] * v[j][1]) + (v[j][2] * v[j][2] + v[j][3] * v[j][3]); }
          s = wave_sum(s);
          u32x2* o = (u32x2*)(xb + (size_t)m * DM) + lane;
#pragma unroll
          for (int j = 0; j < 4; ++j) { u32x2 w; w.x = pk2(v[j][0], v[j][1]); w.y = pk2(v[j][2], v[j][3]); o[64 * j] = w; }
          if (lane < 16) ssq[(size_t)m * 16 + lane] = (lane == 0) ? s : 0.f;
      } }
}

struct MixW { const float *rpb, *dw_w, *dw_b, *cln_g, *cln_b, *sln_g, *sln_b, *sgu_b; const bf16_t *PWT, *POOLT, *SGW; };

#define LANE_VARS int tid = tid0; asm volatile("" : "+v"(tid)); const int lane = tid & 63, fr = lane & 15, fq = lane >> 4, c0 = half * 128 + 2 * lane; (void)fr; (void)fq; (void)c0;
#define CONV_LOAD(k) do { const int task_ = tid + (k) * NT, tt_ = task_ >> 5, ch_ = task_ & 31, s_ = r * 64 - 15 + tt_; \
        cav[k] = (u32x4){0u, 0u, 0u, 0u}; cbv[k] = cav[k]; \
        if (task_ < 94 * 32 && s_ >= 0 && s_ < SEQ) { cav[k] = *(const u32x4*)(Zb + (size_t)s_ * DIN + 768 + ch_ * 8); cbv[k] = *(const u32x4*)(Zb + (size_t)s_ * DIN + 1024 + ch_ * 8); } } while (0)
__device__ __forceinline__ void na_stage(const bf16_t* Z, const bf16_t* Zb, const bf16_t* VT, bf16_t* Y, LAS float* rpbL, int b, int r, int tok0, int wid, int tid0, int half, u32x4 (&cav)[6], u32x4 (&cbv)[6]) {
    const f32x4 zero4 = {0.f, 0.f, 0.f, 0.f};
    LANE_VARS
    const int h = wid, rs = min(max(r - 4, 0), 24);
    const bf16_t* VTh = VT + (size_t)(b * 8 + h) * 32 * SEQ;
    const int kperm = (fr >> 2) * 8 + (fr & 3);
#define NA_CW0(qb) ((qb) == 0 ? 0 : ((qb) == 1 ? 8 : ((qb) == 2 ? 24 : 32)))
    const int klane = kperm * DIN + fq * 8, qlane = fr * DIN + fq * 8, vlane = fr * SEQ + fq * 8, glane = fr * DIN + 4 * fq;
    const bf16_t* Kh = Zb + (size_t)rs * 64 * DIN + 256 + h * 32;
#define NA_KLOAD(dst, qb) do { _Pragma("unroll") for (int j = 0; j < 8; ++j) _Pragma("unroll") for (int t = 0; t < 2; ++t) \
        dst[j][t] = *(const bf16x8*)((Kh + (size_t)(j * 64 + NA_CW0(qb) + t * 4) * DIN) + klane); } while (0)
#define NA_QLOAD(qb) (*(const bf16x8*)((Zb + (size_t)(r * 64 + 16 * (qb)) * DIN + h * 32) + qlane))
    bf16x8 qcur = NA_QLOAD(0), qnxt = qcur;
    bf16x8 kf[8][2];
    NA_KLOAD(kf, 0);
    __builtin_amdgcn_sched_barrier(0);
#pragma unroll
    for (int qb = 0; qb < 4; ++qb) {
        const int c = 16 * qb + fr, cw0 = NA_CW0(qb), cs = min(max(c - 8, 0), 48);
        f32x4 S[8][2];
#pragma unroll
        for (int j = 0; j < 8; ++j)
#pragma unroll
            for (int t = 0; t < 2; ++t) S[j][t] = MFMA16(kf[j][t], qcur, zero4);
        __builtin_amdgcn_sched_barrier(0);
        bf16x8 vf[8][2];
#pragma unroll
        for (int j = 0; j < 8; ++j)
#pragma unroll
            for (int dt = 0; dt < 2; ++dt) vf[j][dt] = *(const bf16x8*)((VTh + (size_t)(dt * 16) * SEQ + (rs + j) * 64 + cw0) + vlane);
        u32x2 gv[2];
#pragma unroll
        for (int dt = 0; dt < 2; ++dt) gv[dt] = *(const u32x2*)((Z + (size_t)(tok0 + 16 * qb) * DIN + 2048 + h * 32 + dt * 16) + glane);
        __builtin_amdgcn_sched_barrier(0);
        float mx = -INFINITY;
#pragma unroll
        for (int j = 0; j < 8; ++j) {
            const LAS float* rp = rpbL + h * 465 + (rs + j - r + 7) * 31 + 15;
#pragma unroll
            for (int t = 0; t < 2; ++t)
#pragma unroll
                for (int e = 0; e < 4; ++e) {
                    const int kc = cw0 + fq * 8 + t * 4 + e; const bool valid = (kc >= cs) && (kc < cs + 16);
                    const int dc = min(max(kc - c, -15), 15);
                    float sv = S[j][t][e] + rp[dc]; sv = valid ? sv : -INFINITY; S[j][t][e] = sv; mx = fmaxf(mx, sv);
                }
            if (j & 1) __builtin_amdgcn_sched_barrier(0);
        }
        mx = fmaxf(mx, __shfl_xor(mx, 16)); mx = fmaxf(mx, __shfl_xor(mx, 32));
        float sum = 0.f;
#pragma unroll
        for (int j = 0; j < 8; ++j)
#pragma unroll
            for (int t = 0; t < 2; ++t)
#pragma unroll
                for (int e = 0; e < 4; ++e) { const float p = __builtin_amdgcn_exp2f((S[j][t][e] - mx) * 1.44269504f); S[j][t][e] = p; sum += p; }
        sum += __shfl_xor(sum, 16); sum += __shfl_xor(sum, 32);
        const float inv = frcp(sum);
        f32x4 O[2] = {zero4, zero4};
        bf16x8 pf[8];
#pragma unroll
        for (int j = 0; j < 8; ++j) {
            u32x4 pw; pw.x = pk2(S[j][0][0], S[j][0][1]); pw.y = pk2(S[j][0][2], S[j][0][3]); pw.z = pk2(S[j][1][0], S[j][1][1]); pw.w = pk2(S[j][1][2], S[j][1][3]);
            pf[j] = __builtin_bit_cast(bf16x8, pw);
        }
        __builtin_amdgcn_sched_barrier(0);
        if (qb < 3) { qnxt = NA_QLOAD(qb + 1); NA_KLOAD(kf, qb + 1); }
        else {
#pragma unroll
            for (int k = 0; k < 6; ++k) CONV_LOAD(k);
        }
        __builtin_amdgcn_sched_barrier(0);
#pragma unroll
        for (int j = 0; j < 8; ++j)
#pragma unroll
            for (int dt = 0; dt < 2; ++dt) O[dt] = MFMA16(vf[j][dt], pf[j], O[dt]);
#pragma unroll
        for (int dt = 0; dt < 2; ++dt) {
            const int ch = h * 32 + dt * 16 + 4 * fq;
            u32x2 w; w.x = pk2(O[dt][0] * inv * bf_lo(gv[dt].x), O[dt][1] * inv * bf_hi(gv[dt].x)); w.y = pk2(O[dt][2] * inv * bf_lo(gv[dt].y), O[dt][3] * inv * bf_hi(gv[dt].y));
            *(u32x2*)(Y + (size_t)(tok0 + c) * DM + ch) = w;
        }
        qcur = qnxt;
        __builtin_amdgcn_sched_barrier(0);
    }
}

__device__ __forceinline__ void mixer_phase(LAS unsigned char* lds, const bf16_t* Z, const bf16_t* VT, bf16_t* Y, const MixW& W) {
    const int tid0 = threadIdx.x, wid = __builtin_amdgcn_readfirstlane(tid0 >> 6);
    LAS float* rpbL = (LAS float*)(lds + RPB_OFF);
    for (int i = tid0; i < 8 * 465; i += NT) rpbL[i] = W.rpb[i];
    const f32x4 zero4 = {0.f, 0.f, 0.f, 0.f};
    const int tq = wid >> 1, half = wid & 1;
    for (int item = blockIdx.x; item < 256; item += gridDim.x) {
        LBAR();
        const int b = item & 7, r = item >> 3, tok0 = b * SEQ + r * 64;
        const bf16_t* Zb = Z + (size_t)b * SEQ * DIN;
        u32x4 cav[6], cbv[6];
        u32x4 pv[5];
        u32x2 raw[16];
        na_stage(Z, Zb, VT, Y, rpbL, b, r, tok0, wid, tid0, half, cav, cbv);
        {
            LANE_VARS
            LAS unsigned char* Hb = lds + L_R0; LAS unsigned char* Hn = lds + L_R0; LAS unsigned char* Cf = lds + L_R1; LAS f32x2* stat = (LAS f32x2*)(lds + L_STAT);
            const int cb = (r & ~1) * 64;
#pragma unroll
            for (int k = 0; k < 6; ++k) {
                const int task = tid + k * NT, tt = task >> 5, ch = task & 31;
                u32x4 o;
#pragma unroll
                for (int e = 0; e < 4; ++e) { const float a0 = bf_lo(cav[k][e]), a1 = bf_hi(cav[k][e]), b0 = bf_lo(cbv[k][e]), b1 = bf_hi(cbv[k][e]);
                    o[e] = pk2(a0 * frcp(1.f + fexp(-b0)), a1 * frcp(1.f + fexp(-b1))); }
                if (task < 94 * 32) *(LAS u32x4*)(Hb + tt * ROWB + ch * 16) = o;
            }
            __builtin_amdgcn_sched_barrier(0);
#pragma unroll
            for (int k = 0; k < 5; ++k) {
                const int task = tid + k * NT, tt = task >> 5, ch = task & 31, s = r * 64 - 8 + tt;
                pv[k] = (u32x4){0u, 0u, 0u, 0u};
                if (task < 79 * 32 && s >= 0 && s < SEQ) pv[k] = *(const u32x4*)(Zb + (size_t)s * DIN + 1280 + ch * 8);
            }
#pragma unroll
            for (int i = 0; i < 16; ++i) raw[i] = *(const u32x2*)(Zb + (size_t)(cb + wid * 16 + i) * DIN + 1792 + 4 * lane);
            f32x2 wv[31];
#pragma unroll
            for (int j = 0; j < 31; ++j) wv[j] = *(const f32x2*)(W.dw_w + j * 256 + c0);
            const f32x2 bias = *(const f32x2*)(W.dw_b + c0);
            __builtin_amdgcn_sched_barrier(0);
            LBAR();
#pragma unroll 1
            for (int p = 0; p < 2; ++p) {
                const int tb = tq * 16 + p * 8;
                float a0[8], a1[8];
#pragma unroll
                for (int t = 0; t < 8; ++t) { a0[t] = bias[0]; a1[t] = bias[1]; }
#pragma unroll
                for (int jg = 0; jg < 40; jg += 8) {
                    unsigned hv[8];
#pragma unroll
                    for (int i = 0; i < 8; ++i) if (jg + i < 38) hv[i] = *(const LAS unsigned*)(Hb + (tb + jg + i) * ROWB + c0 * 2);
#pragma unroll
                    for (int i = 0; i < 8; ++i) if (jg + i < 38) {
                        const int jj = jg + i; const float v0 = bf_lo(hv[i]), v1 = bf_hi(hv[i]);
#pragma unroll
                        for (int t = 0; t < 8; ++t) { const int tap = jj - t; if (tap >= 0 && tap <= 30) { a0[t] += v0 * wv[tap][0]; a1[t] += v1 * wv[tap][1]; } }
                    }
                    __builtin_amdgcn_sched_barrier(0);
                }
#pragma unroll
                for (int t = 0; t < 8; ++t) {
                    const float s1 = wave_sum(a0[t] + a1[t]), s2 = wave_sum(a0[t] * a0[t] + a1[t] * a1[t]);
                    if (lane == 0) stat[(tb + t) * 2 + half] = (f32x2){s1, s2};
                    *(LAS f32x2*)(Cf + ((tb + t) * 256 + c0) * 4) = (f32x2){a0[t], a1[t]};
                }
            }
            const f32x2 lg = *(const f32x2*)(W.cln_g + c0), lb = *(const f32x2*)(W.cln_b + c0);
            bf16x8 afw[8][2];
#pragma unroll
            for (int ks = 0; ks < 8; ++ks)
#pragma unroll
                for (int nt = 0; nt < 2; ++nt) afw[ks][nt] = *(const bf16x8*)(W.PWT + (size_t)(wid * 32 + nt * 16 + fr) * 256 + ks * 32 + fq * 8);
            u32x2 gvv[2][4];
#pragma unroll
            for (int nt = 0; nt < 2; ++nt)
#pragma unroll
                for (int tt = 0; tt < 4; ++tt) gvv[nt][tt] = *(const u32x2*)(Z + (size_t)(tok0 + tt * 16 + fr) * DIN + 2048 + 256 + wid * 32 + nt * 16 + 4 * fq);
            __builtin_amdgcn_sched_barrier(0);
            LBAR();
#pragma unroll 4
            for (int t = 0; t < 16; ++t) {
                const f32x2 p = stat[(tq * 16 + t) * 2], q = stat[(tq * 16 + t) * 2 + 1];
                const f32x2 cv = *(const LAS f32x2*)(Cf + ((tq * 16 + t) * 256 + c0) * 4);
                const float mean = (p[0] + q[0]) * (1.f / 256.f), var = (p[1] + q[1]) * (1.f / 256.f) - mean * mean, rstd = __builtin_amdgcn_rsqf(var + 1e-5f);
                const float y0 = (cv[0] - mean) * rstd * lg[0] + lb[0], y1 = (cv[1] - mean) * rstd * lg[1] + lb[1];
                *(LAS unsigned*)(Hn + (tq * 16 + t) * ROWB + c0 * 2) = pk2(silu_f(y0), silu_f(y1));
            }
            LBAR();
            f32x4 acc[2][4];
#pragma unroll
            for (int nt = 0; nt < 2; ++nt)
#pragma unroll
                for (int tt = 0; tt < 4; ++tt) acc[nt][tt] = zero4;
#pragma unroll
            for (int ks = 0; ks < 8; ++ks) {
                bf16x8 bfr[4];
#pragma unroll
                for (int tt = 0; tt < 4; ++tt) bfr[tt] = *(const LAS bf16x8*)(Hn + (tt * 16 + fr) * ROWB + (ks * 32 + fq * 8) * 2);
#pragma unroll
                for (int nt = 0; nt < 2; ++nt)
#pragma unroll
                    for (int tt = 0; tt < 4; ++tt) acc[nt][tt] = MFMA16(afw[ks][nt], bfr[tt], acc[nt][tt]);
            }
#pragma unroll
            for (int nt = 0; nt < 2; ++nt)
#pragma unroll
                for (int tt = 0; tt < 4; ++tt) {
                    const int ch = wid * 32 + nt * 16 + 4 * fq; const size_t tok = (size_t)(tok0 + tt * 16 + fr);
                    const u32x2 gv = gvv[nt][tt];
                    u32x2 w; w.x = pk2(acc[nt][tt][0] * bf_lo(gv.x), acc[nt][tt][1] * bf_hi(gv.x)); w.y = pk2(acc[nt][tt][2] * bf_lo(gv.y), acc[nt][tt][3] * bf_hi(gv.y));
                    *(u32x2*)(Y + tok * DM + 256 + ch) = w;
                }
        }
        {
            LANE_VARS
            LAS unsigned char* Pin = lds + L_R1; LAS unsigned char* Pn = lds + L_R2;
#pragma unroll
            for (int k = 0; k < 5; ++k) { const int task = tid + k * NT, tt = task >> 5, ch = task & 31; if (task < 79 * 32) *(LAS u32x4*)(Pin + tt * ROWB + ch * 16) = pv[k]; }
            bf16x8 afp[2][2];
#pragma unroll
            for (int ks = 0; ks < 2; ++ks)
#pragma unroll
                for (int nt = 0; nt < 2; ++nt) afp[ks][nt] = *(const bf16x8*)(W.POOLT + (size_t)(wid * 32 + nt * 16 + fr) * 64 + ks * 32 + fq * 8);
            u32x2 gvp[2][4];
#pragma unroll
            for (int nt = 0; nt < 2; ++nt)
#pragma unroll
                for (int tt = 0; tt < 4; ++tt) gvp[nt][tt] = *(const u32x2*)(Z + (size_t)(tok0 + tt * 16 + fr) * DIN + 2048 + 512 + wid * 32 + nt * 16 + 4 * fq);
            __builtin_amdgcn_sched_barrier(0);
            LBAR();
            {
                const int g = half * 2 + (lane >> 5), w = 2 << g, hw = w >> 1;
#pragma unroll 4
                for (int t = 0; t < 16; ++t) {
                    const int ta = tq * 16 + t, s = r * 64 + ta;
                    const int lo = max(s - hw, 0), hi = min(s - hw + w, SEQ);
                    float p0 = 0.f, p1 = 0.f;
#pragma unroll
                    for (int i = 0; i < 16; ++i) if (i < w) { const unsigned v = *(const LAS unsigned*)(Pin + (ta + 8 - hw + i) * ROWB + c0 * 2); p0 += bf_lo(v); p1 += bf_hi(v); }
                    const unsigned xc = *(const LAS unsigned*)(Pin + (ta + 8) * ROWB + c0 * 2);
                    const float ic = 1.f / (float)(hi - lo);
                    *(LAS unsigned*)(Pn + ta * ROWB + c0 * 2) = pk2(p0 * ic - bf_lo(xc), p1 * ic - bf_hi(xc));
                }
            }
            LBAR();
            f32x4 acc[2][4];
#pragma unroll
            for (int nt = 0; nt < 2; ++nt)
#pragma unroll
                for (int tt = 0; tt < 4; ++tt) acc[nt][tt] = zero4;
            const int g = wid >> 1;
#pragma unroll
            for (int ks = 0; ks < 2; ++ks) {
                bf16x8 bfr[4];
#pragma unroll
                for (int tt = 0; tt < 4; ++tt) bfr[tt] = *(const LAS bf16x8*)(Pn + (tt * 16 + fr) * ROWB + (g * 64 + ks * 32 + fq * 8) * 2);
#pragma unroll
                for (int nt = 0; nt < 2; ++nt)
#pragma unroll
                    for (int tt = 0; tt < 4; ++tt) acc[nt][tt] = MFMA16(afp[ks][nt], bfr[tt], acc[nt][tt]);
            }
#pragma unroll
            for (int nt = 0; nt < 2; ++nt)
#pragma unroll
                for (int tt = 0; tt < 4; ++tt) {
                    const int ch = wid * 32 + nt * 16 + 4 * fq; const size_t tok = (size_t)(tok0 + tt * 16 + fr);
                    const u32x2 gv = gvp[nt][tt];
                    u32x2 w; w.x = pk2(acc[nt][tt][0] * bf_lo(gv.x), acc[nt][tt][1] * bf_hi(gv.x)); w.y = pk2(acc[nt][tt][2] * bf_lo(gv.y), acc[nt][tt][3] * bf_hi(gv.y));
                    *(u32x2*)(Y + tok * DM + 512 + ch) = w;
                }
        }
        {
            LANE_VARS
            LAS unsigned char* vnT = lds;
            const int ph = r & 1;
            const f32x4 lg = *(const f32x4*)(W.sln_g + 4 * lane), lb = *(const f32x4*)(W.sln_b + 4 * lane);
            const int h = wid >> 1, dh = wid & 1;
            bf16x8 bsw[4][4];
#pragma unroll
            for (int ks = 0; ks < 4; ++ks)
#pragma unroll
                for (int pt = 0; pt < 4; ++pt) bsw[ks][pt] = *(const bf16x8*)(W.SGW + (size_t)(h * 128 + ph * 64 + pt * 16 + fr) * 128 + ks * 32 + fq * 8);
            u32x2 uvv[4][2], gvs[4][2];
#pragma unroll
            for (int pt = 0; pt < 4; ++pt)
#pragma unroll
                for (int dt = 0; dt < 2; ++dt) { const size_t o = (size_t)(tok0 + pt * 16 + fr) * DIN + h * 64 + (2 * dh + dt) * 16 + 4 * fq; uvv[pt][dt] = *(const u32x2*)(Z + o + 1536); gvs[pt][dt] = *(const u32x2*)(Z + o + 2048 + 768); }
            __builtin_amdgcn_sched_barrier(0);
#pragma unroll
            for (int i = 0; i < 16; ++i) {
                const int q = wid * 16 + i;
                const float x0 = bf_lo(raw[i].x), x1 = bf_hi(raw[i].x), x2 = bf_lo(raw[i].y), x3 = bf_hi(raw[i].y);
                const float sm = wave_sum((x0 + x1) + (x2 + x3)), sq = wave_sum((x0 * x0 + x1 * x1) + (x2 * x2 + x3 * x3));
                const float mean = sm * (1.f / 256.f), var = sq * (1.f / 256.f) - mean * mean, rstd = __builtin_amdgcn_rsqf(var + 1e-5f);
                LAS unsigned char* dst = vnT + (4 * lane) * VNT_ROWB + q * 2;
                *(LAS unsigned short*)(dst) = bf1((x0 - mean) * rstd * lg[0] + lb[0]);
                *(LAS unsigned short*)(dst + VNT_ROWB) = bf1((x1 - mean) * rstd * lg[1] + lb[1]);
                *(LAS unsigned short*)(dst + 2 * VNT_ROWB) = bf1((x2 - mean) * rstd * lg[2] + lb[2]);
                *(LAS unsigned short*)(dst + 3 * VNT_ROWB) = bf1((x3 - mean) * rstd * lg[3] + lb[3]);
            }
            LBAR();
            f32x4 acc[2][4];
#pragma unroll
            for (int dt = 0; dt < 2; ++dt)
#pragma unroll
                for (int pt = 0; pt < 4; ++pt) acc[dt][pt] = zero4;
#pragma unroll
            for (int ks = 0; ks < 4; ++ks) {
                bf16x8 af[2];
#pragma unroll
                for (int dt = 0; dt < 2; ++dt) af[dt] = *(const LAS bf16x8*)(vnT + (h * 64 + (2 * dh + dt) * 16 + fr) * VNT_ROWB + (ks * 32 + fq * 8) * 2);
#pragma unroll
                for (int dt = 0; dt < 2; ++dt)
#pragma unroll
                    for (int pt = 0; pt < 4; ++pt) acc[dt][pt] = MFMA16(af[dt], bsw[ks][pt], acc[dt][pt]);
            }
#pragma unroll
            for (int pt = 0; pt < 4; ++pt) {
                const float bsv = W.sgu_b[h * 128 + ph * 64 + pt * 16 + fr]; const size_t tok = (size_t)(tok0 + pt * 16 + fr);
#pragma unroll
                for (int dt = 0; dt < 2; ++dt) {
                    const int ch = h * 64 + (2 * dh + dt) * 16 + 4 * fq;
                    const u32x2 uv = uvv[pt][dt], gv = gvs[pt][dt];
                    u32x2 w; w.x = pk2((acc[dt][pt][0] + bsv) * bf_lo(uv.x) * bf_lo(gv.x), (acc[dt][pt][1] + bsv) * bf_hi(uv.x) * bf_hi(gv.x));
                    w.y = pk2((acc[dt][pt][2] + bsv) * bf_lo(uv.y) * bf_lo(gv.y), (acc[dt][pt][3] + bsv) * bf_hi(uv.y) * bf_hi(gv.y));
                    *(u32x2*)(Y + tok * DM + 768 + ch) = w;
                }
            }
        }
    }
}

__device__ __forceinline__ void final_phase(float* out, const float* ssq, const float* fg) {
    const int tid = threadIdx.x, lane = tid & 63, wave = tid >> 6;
    const int gw = blockIdx.x * NWAVES + wave, NGW = gridDim.x * NWAVES;
    f32x4 g[4];
#pragma unroll
    for (int j = 0; j < 4; ++j) g[j] = *((const f32x4*)fg + lane + 64 * j);
    for (int m = gw; m < M; m += NGW) {
        const f32x4* sp = (const f32x4*)(ssq + (size_t)m * 16);
        const f32x4 st = (sp[0] + sp[1]) + (sp[2] + sp[3]);
        const float rs = __builtin_amdgcn_rsqf(((st[0] + st[1]) + (st[2] + st[3])) * (1.0f / 1024.0f) + 1e-6f);
        f32x4* xr = (f32x4*)(out + (size_t)m * DM) + lane;
        f32x4 v[4];
#pragma unroll
        for (int j = 0; j < 4; ++j) v[j] = xr[64 * j];
#pragma unroll
        for (int j = 0; j < 4; ++j) xr[64 * j] = v[j] * rs * g[j];
    }
}

__global__ void __launch_bounds__(NT, 2) fwd_megakernel(Args a) {
    extern __shared__ __attribute__((aligned(16))) unsigned char lds_raw[];
    LAS unsigned char* lds = (LAS unsigned char*)lds_raw;
    cg::grid_group grid = cg::this_grid();
    volatile LAS unsigned* bst = (volatile LAS unsigned*)(lds + BAR_LDS_OFF);
    if (threadIdx.x < 2) bst[threadIdx.x] = 0u;
    __syncthreads();
    XcdBarrier bar = xcd_barrier_post((unsigned*)a.ws, bst);
    unsigned char* ws = a.ws;
    const int lo = a.ph_lo, hi = a.ph_hi;
#define IN(k) (lo <= (k) && (k) < hi)
#define SEAM(k) do { if (IN(k) && IN((k) + 1)) { if (USE_CG_SYNC && (k) == 0) grid.sync(); else xcd_barrier(bar); } } while (0)
    bf16_t* XB = (bf16_t*)(ws + WS_XB); bf16_t* Zp = (bf16_t*)(ws + WS_Z); bf16_t* VT = (bf16_t*)(ws + WS_VT); bf16_t* Yp = (bf16_t*)(ws + WS_Y); float* ssq = (float*)(ws + WS_SSQ);
    if ((PHMASK & 1) && IN(0)) { for (int rep = 0; rep < PROREP; ++rep) { prologue(lds, a); __syncthreads(); } }
    SEAM(0);
    for (int l = 0; l < DEPTH; ++l) {
        const int p0 = 1 + 3 * l;
        if ((PHMASK & 2) && IN(p0)) {
            pg8::Gemm g{XB, (const bf16_t*)(ws + WS_WIN) + (size_t)l * DIN * DM, M, DIN, DM}; pg8::StaticOrder S; S.init(M, DIN, (int)gridDim.x, (int)blockIdx.x);
            pg8::EpiZ E{Zp, VT, ssq};
            for (int rep = 0; rep < G1REP; ++rep) pg8::gemm_phase<pg8::EpiZ, pg8::StaticOrder, true, true>(lds, g, S, E);
        }
        SEAM(p0);
        if ((PHMASK & 4) && IN(p0 + 1)) {
            MixW W;
            W.rpb = a.in[3] + (size_t)l * 8 * 465; W.dw_w = a.in[4] + (size_t)l * 31 * 256; W.dw_b = a.in[5] + l * 256; W.cln_g = a.in[6] + l * 256; W.cln_b = a.in[7] + l * 256;
            W.sln_g = a.in[11] + l * 256; W.sln_b = a.in[12] + l * 256; W.sgu_b = a.in[14] + l * 512;
            W.PWT = (const bf16_t*)(ws + WS_PW) + (size_t)l * 65536; W.POOLT = (const bf16_t*)(ws + WS_POOL) + (size_t)l * 16384; W.SGW = (const bf16_t*)(ws + WS_SGW) + (size_t)l * 65536;
            for (int rep = 0; rep < MIXREP; ++rep) mixer_phase(lds, Zp, VT, Yp, W);
            __syncthreads();
        }
        SEAM(p0 + 1);
        if ((PHMASK & 8) && IN(p0 + 2)) {
            pg8::Gemm g{Yp, (const bf16_t*)(ws + WS_WOUT) + (size_t)l * DM * DM, M, DM, DM}; pg8::StaticOrder S; S.init(M, DM, (int)gridDim.x, (int)blockIdx.x);
            pg8::EpiX E{l == 0 ? a.in[0] : a.out, a.out, XB, ssq, l + 1 < DEPTH ? 1 : 0};
            for (int rep = 0; rep < (l == 0 ? G2REP : 1); ++rep) pg8::gemm_phase<pg8::EpiX, pg8::StaticOrder, true, true>(lds, g, S, E);
        }
        SEAM(p0 + 2);
    }
    if ((PHMASK & 16) && IN(7)) final_phase(a.out, ssq, a.in[16]);
#undef IN
#undef SEAM
}

extern "C" void kernel_launch(void* const* d_in, const int* in_sizes, int n_in, void* d_out, int out_size, void* d_ws, size_t ws_size, hipStream_t stream) {
    static int grid = 0;
    if (grid == 0) {
        if (n_in != 17 || in_sizes[0] != M * DM || out_size != M * DM || ws_size < WS_END) { fprintf(stderr, "kernel_launch: unexpected shapes (n_in %d, in0 %d, out %d, ws %zu)\n", n_in, n_in > 0 ? in_sizes[0] : -1, out_size, ws_size); grid = -1; return; }
        int dev = 0, cus = 0, per_cu = 0;
        if (hipGetDevice(&dev) != hipSuccess || hipDeviceGetAttribute(&cus, hipDeviceAttributeMultiprocessorCount, dev) != hipSuccess) { grid = -1; return; }
        if (hipFuncSetAttribute((const void*)fwd_megakernel, hipFuncAttributeMaxDynamicSharedMemorySize, LDS_BYTES) != hipSuccess) { fprintf(stderr, "kernel_launch: hipFuncSetAttribute failed\n"); grid = -1; return; }
        if (hipOccupancyMaxActiveBlocksPerMultiprocessor(&per_cu, (const void*)fwd_megakernel, NT, LDS_BYTES) != hipSuccess || per_cu < 1) { fprintf(stderr, "kernel_launch: occupancy query gave %d\n", per_cu); per_cu = 1; }
        (void)hipGetLastError();
        grid = cus * per_cu;
    }
    if (grid < 0) return;
    Args a{};
    for (int i = 0; i < 17; ++i) a.in[i] = (const float*)d_in[i];
    a.out = (float*)d_out; a.ws = (unsigned char*)d_ws;
    if (MK_N_LAUNCHES == 1) {
        a.ph_lo = 0; a.ph_hi = 8;
        if (hipMemsetAsync(d_ws, 0, 16384, stream) != hipSuccess) { fprintf(stderr, "kernel_launch: memset of the barrier words failed\n"); return; }
        void* args[] = {&a};
        hipError_t e = hipLaunchCooperativeKernel((const void*)fwd_megakernel, dim3(grid), dim3(NT), args, LDS_BYTES, stream);
        if (e != hipSuccess) fprintf(stderr, "cooperative launch failed: %s (grid %d)\n", hipGetErrorString(e), grid);
    } else {
        for (int p = 0; p < 8; ++p) {
            a.ph_lo = p; a.ph_hi = p + 1;
            hipLaunchKernelGGL(fwd_megakernel, dim3(grid), dim3(NT), LDS_BYTES, stream, a);
        }
    }
}
```

```cpp
#include <hip/hip_runtime.h>
#include <hip/hip_cooperative_groups.h>
#include <cstdio>
#include <cstdint>
namespace cg = cooperative_groups;
#ifndef MK_N_LAUNCHES
#define MK_N_LAUNCHES 1
#endif
typedef float f32x2 __attribute__((ext_vector_type(2)));
typedef unsigned u32x2 __attribute__((ext_vector_type(2)));
__device__ __forceinline__ unsigned pk2(float lo, float hi) {
    typedef __bf16 bf2 __attribute__((ext_vector_type(2)));
    bf2 v = __builtin_convertvector((f32x2){lo, hi}, bf2);
    return __builtin_bit_cast(unsigned, v);
}
__device__ __forceinline__ unsigned short bf1(float x) { __bf16 v = (__bf16)x; return __builtin_bit_cast(unsigned short, v); }
__device__ __forceinline__ float bf_lo(unsigned u) { return __uint_as_float(u << 16); }
__device__ __forceinline__ float bf_hi(unsigned u) { return __uint_as_float(u & 0xffff0000u); }
__device__ __forceinline__ float fexp(float x) { return __builtin_amdgcn_exp2f(x * 1.44269504f); }
__device__ __forceinline__ float frcp(float x) { return __builtin_amdgcn_rcpf(x); }
__device__ __forceinline__ float silu_f(float x) { return x * frcp(1.f + fexp(-x)); }
__device__ __forceinline__ float gelu_f(float x) { const float u = 0.7978845608f * (x + 0.044715f * x * x * x); return x * frcp(1.f + fexp(-2.f * u)); }
template <int CTRL> __device__ __forceinline__ float dpp_mov(float v) { return __builtin_bit_cast(float, __builtin_amdgcn_update_dpp(0, __builtin_bit_cast(int, v), CTRL, 0xf, 0xf, false)); }
__device__ __forceinline__ float wave_sum(float v) {
    v += dpp_mov<0xB1>(v);
    v += dpp_mov<0x4E>(v);
    v += dpp_mov<0x141>(v);
    v += dpp_mov<0x140>(v);
    const int vi = __builtin_bit_cast(int, v);
    const float r0 = __builtin_bit_cast(float, __builtin_amdgcn_readlane(vi, 0)), r1 = __builtin_bit_cast(float, __builtin_amdgcn_readlane(vi, 16));
    const float r2 = __builtin_bit_cast(float, __builtin_amdgcn_readlane(vi, 32)), r3 = __builtin_bit_cast(float, __builtin_amdgcn_readlane(vi, 48));
    return (r0 + r1) + (r2 + r3);
}
namespace pg8 {
#define PG8_LAS __attribute__((address_space(3)))
typedef unsigned short bf16_t;
typedef short bf16x8 __attribute__((ext_vector_type(8)));
typedef float f32x4 __attribute__((ext_vector_type(4)));
typedef unsigned u32x4 __attribute__((ext_vector_type(4)));
constexpr int BM = 256, BK = 64, HALF = 128, HTB = HALF * BK * 2  , STAGE_BYTES = 8 * HTB, NXCD = 8, WGM = 8;

__host__ __device__ __forceinline__ int lds_byte(int r, int c) { const int st = (r >> 4) * 2 + (c >> 5), rr = r & 15, cc = c & 31, ob = rr * 64 + cc * 2; return st * 1024 + (ob ^ (((ob >> 9) & 1) << 5)); }
__host__ __device__ __forceinline__ void stage_rc(int b, int& R, int& C) { const int st = b / 1024, sb = b % 1024, swz = sb ^ (((sb >> 9) & 1) << 5); R = (st >> 1) * 16 + swz / 64; C = (st & 1) * 32 + (swz % 64) / 2; }
__host__ __device__ __forceinline__ int perm32(int rho) { const int n = rho >> 4, i = rho & 15; return 8 * (i >> 2) + 4 * n + (i & 3); }

struct Unit { int pm, pn; };
struct Gemm { const bf16_t* A; const bf16_t* Bt; int M, N, K; };

struct StaticOrder {
    int nM, nN, nwg, G, c;
    __host__ __device__ void init(int M, int N, int G_, int c_) { nM = M / BM; nN = N / BM; nwg = nM * nN; G = G_; c = c_; }
    __host__ __device__ bool next(int i, Unit& u) const {
        const long L = (long)i * G + c; if (L >= nwg) return false;
        int wgid = (int)L; { const int q = nwg / NXCD, r = nwg % NXCD, xcd = wgid % NXCD, off = wgid / NXCD; wgid = (xcd < r ? xcd * (q + 1) : r * (q + 1) + (xcd - r) * q) + off; }
        const int nig = WGM * nN, gid = wgid / nig, fm = gid * WGM, gsz = (nM - fm) < WGM ? (nM - fm) : WGM;
        u.pm = fm + ((wgid % nig) % gsz); u.pn = (wgid % nig) / gsz; return true;
    }
    __device__ __forceinline__ void a_ready(const Unit&) const {}
    __device__ __forceinline__ void done(const Unit&) const {}
};
struct EpiZ {
    static constexpr bool PERM = true, AFTER_DRAIN = false;
    bf16_t* Z; bf16_t* VT; const float* ssq;
    __device__ __forceinline__ void operator()(const f32x4 (&acc)[2][2][4][2], const Unit& u, int wr, int wc, int fr, int fq) const {
        const int row0 = u.pm * BM + wr * 64 + fr, pn = u.pn, col0 = pn * BM + wc * 32 + 8 * fq;
        const int act = (pn >= 8) ? 2 : (pn >= 6 ? 1 : 0);
#pragma unroll
        for (int ai = 0; ai < 2; ++ai)
#pragma unroll
            for (int m = 0; m < 4; ++m) {
                const int row = row0 + ai * HALF + m * 16;
                const f32x4* sp = (const f32x4*)(ssq + (size_t)row * 16);
                const f32x4 st = (sp[0] + sp[1]) + (sp[2] + sp[3]);
                const float rs = __builtin_amdgcn_rsqf(((st[0] + st[1]) + (st[2] + st[3])) * (1.0f / 1024.0f) + 1e-6f);
#pragma unroll
                for (int bj = 0; bj < 2; ++bj) {
                    f32x4 v0 = acc[ai][bj][m][0] * rs, v1 = acc[ai][bj][m][1] * rs;
                    if (act == 1) {
#pragma unroll
                        for (int e = 0; e < 4; ++e) { v0[e] = gelu_f(v0[e]); v1[e] = gelu_f(v1[e]); }
                    } else if (act == 2) {
#pragma unroll
                        for (int e = 0; e < 4; ++e) { v0[e] = silu_f(v0[e]); v1[e] = silu_f(v1[e]); }
                    }
                    if (pn == 2) {
                        const int b = row >> 11, s = row & 2047, h = 4 * bj + wc;
                        bf16_t* vp = VT + ((size_t)((b * 8 + h) * 32 + 8 * fq)) * 2048 + s;
#pragma unroll
                        for (int e = 0; e < 4; ++e) { vp[(size_t)e * 2048] = bf1(v0[e]); vp[(size_t)(4 + e) * 2048] = bf1(v1[e]); }
                    } else {
                        u32x4 w; w.x = pk2(v0[0], v0[1]); w.y = pk2(v0[2], v0[3]); w.z = pk2(v1[0], v1[1]); w.w = pk2(v1[2], v1[3]);
                        *(u32x4*)(Z + (size_t)row * 3072 + col0 + bj * HALF) = w;
                    }
                }
            }
    }
};
struct EpiX {
    static constexpr bool PERM = false, AFTER_DRAIN = false;
    const float* xin; float* xout; bf16_t* xb; float* ssq; int write_xb;
    __device__ __forceinline__ void operator()(const f32x4 (&acc)[2][2][4][2], const Unit& u, int wr, int wc, int fr, int fq) const {
        const int row0 = u.pm * BM + wr * 64 + fr, col0 = u.pn * BM + wc * 32 + 4 * fq;
#pragma unroll
        for (int ai = 0; ai < 2; ++ai)
#pragma unroll
            for (int m = 0; m < 4; ++m) {
                const int row = row0 + ai * HALF + m * 16; const size_t off = (size_t)row * 1024 + col0;
                float q = 0.f;
#pragma unroll
                for (int bj = 0; bj < 2; ++bj)
#pragma unroll
                    for (int n = 0; n < 2; ++n) {
                        const f32x4 xv = *(const f32x4*)(xin + off + bj * HALF + n * 16);
                        const f32x4 o = xv + acc[ai][bj][m][n];
                        *(f32x4*)(xout + off + bj * HALF + n * 16) = o;
                        q += (o[0] * o[0] + o[1] * o[1]) + (o[2] * o[2] + o[3] * o[3]);
                        if (write_xb) { u32x2 w; w.x = pk2(o[0], o[1]); w.y = pk2(o[2], o[3]); *(u32x2*)(xb + off + bj * HALF + n * 16) = w; }
                    }
                q += __shfl_xor(q, 16); q += __shfl_xor(q, 32);
                if (fq == 0) ssq[(size_t)row * 16 + u.pn * 4 + wc] = q;
            }
    }
};
template <class Epi, class Sched, bool ALIGN_EPI = false, bool SP2 = false>
__device__ __forceinline__ void gemm_phase(PG8_LAS unsigned char* lds, const Gemm g, const Sched& S, const Epi& E) {
    int tid_ = threadIdx.x; asm volatile("" : "+v"(tid_));
    const int tid = tid_, wid = __builtin_amdgcn_readfirstlane(tid >> 6), lane = tid & 63, wr = wid >> 2, wc = wid & 3, fr = lane & 15, fq = lane >> 4;
    const int K = g.K, nt = K / BK;
    unsigned voffA[2], voffB[2];
#pragma unroll
    for (int i = 0; i < 2; ++i) { int R, C; stage_rc(tid * 16 + i * 8192, R, C); const int Rb = Epi::PERM ? ((R & ~31) + perm32(R & 31)) : R;
        voffA[i] = (unsigned)(R * K + C) * 2u; voffB[i] = (unsigned)(Rb * K + C) * 2u; }
    const size_t kstep = (size_t)(BK * 2);
    const size_t hstep = (size_t)HALF * K * 2;
    const size_t tstep = 2 * hstep;
    const unsigned ldsw = (unsigned)wid * 1024u;
    const int aoff = lds_byte(wr * 64 + fr, fq * 8), boff = lds_byte(wc * 32 + fr, fq * 8);
#define PG8_SA(b, h) (((b) * 2 + (h)) * HTB)
#define PG8_SB(b, h) ((4 + (b) * 2 + (h)) * HTB)
#define PG8_STAGE(bufoff, gbase, voff) do { _Pragma("unroll") for (int _i = 0; _i < 2; ++_i) \
        __builtin_amdgcn_global_load_lds((const unsigned*)((const char*)(gbase) + (voff)[_i]), (PG8_LAS unsigned*)(lds + (bufoff) + ldsw + _i * 8192), 16, 0, 0); } while (0)
#define PG8_LDA(dst, b, h) do { _Pragma("unroll") for (int m = 0; m < 4; ++m) _Pragma("unroll") for (int k = 0; k < 2; ++k) dst[m][k] = *(const PG8_LAS bf16x8*)(lds + PG8_SA(b, h) + aoff + m * 2048 + k * 1024); } while (0)
#define PG8_LDB(dst, b, h) do { _Pragma("unroll") for (int n = 0; n < 2; ++n) _Pragma("unroll") for (int k = 0; k < 2; ++k) dst[n][k] = *(const PG8_LAS bf16x8*)(lds + PG8_SB(b, h) + boff + n * 2048 + k * 1024); } while (0)
#define PG8_MMA(ai, bj, At, Bt) do { __builtin_amdgcn_s_setprio(1); _Pragma("unroll") for (int m = 0; m < 4; ++m) _Pragma("unroll") for (int n = 0; n < 2; ++n) _Pragma("unroll") for (int k = 0; k < 2; ++k) \
        acc[ai][bj][m][n] = __builtin_amdgcn_mfma_f32_16x16x32_bf16(Bt[n][k], At[m][k], acc[ai][bj][m][n], 0, 0, 0); __builtin_amdgcn_s_setprio(0); } while (0)
#define PG8_WAIT_V(n) asm volatile("s_waitcnt vmcnt(" #n ")" ::: "memory")
#define PG8_WAIT_L(n) asm volatile("s_waitcnt lgkmcnt(" #n ")" ::: "memory")
#define PG8_BAR __builtin_amdgcn_s_barrier()
#define PG8_SCHED __builtin_amdgcn_sched_barrier(0)
    Unit cur, nxt; int ui = 0;
    if (!S.next(0, cur)) return;
    f32x4 acc[2][2][4][2];
#pragma unroll
    for (int a = 0; a < 2; ++a)
#pragma unroll
        for (int b = 0; b < 2; ++b)
#pragma unroll
            for (int m = 0; m < 4; ++m)
#pragma unroll
                for (int n = 0; n < 2; ++n) acc[a][b][m][n] = (f32x4){0.f, 0.f, 0.f, 0.f};
    bf16x8 At[4][2], B0[2][2], B1[2][2];
    const char* cA = (const char*)g.A + (size_t)cur.pm * tstep; const char* cB = (const char*)g.Bt + (size_t)cur.pn * tstep;
    S.a_ready(cur);
    if constexpr (SP2) {
        PG8_STAGE(PG8_SB(0, 0), cB, voffB); PG8_STAGE(PG8_SB(0, 1), cB + hstep, voffB); PG8_STAGE(PG8_SA(0, 0), cA, voffA); PG8_STAGE(PG8_SA(0, 1), cA + hstep, voffA);
        if (wr == 1) PG8_BAR;
        PG8_WAIT_V(2); PG8_BAR;
        PG8_STAGE(PG8_SB(1, 0), cB + kstep, voffB); PG8_STAGE(PG8_SA(1, 0), cA + kstep, voffA); PG8_STAGE(PG8_SB(1, 1), cB + hstep + kstep, voffB);
        PG8_WAIT_V(6); PG8_BAR;
    } else {
        PG8_STAGE(PG8_SB(0, 0), cB, voffB); PG8_STAGE(PG8_SA(0, 0), cA, voffA); PG8_STAGE(PG8_SB(0, 1), cB + hstep, voffB); PG8_STAGE(PG8_SA(0, 1), cA + hstep, voffA);
        if (wr == 1) PG8_BAR;
        PG8_WAIT_V(4); PG8_BAR;
        PG8_STAGE(PG8_SB(1, 0), cB + kstep, voffB); PG8_STAGE(PG8_SA(1, 0), cA + kstep, voffA); PG8_STAGE(PG8_SB(1, 1), cB + hstep + kstep, voffB);
        PG8_WAIT_V(6); PG8_BAR;
    }
    for (;;) {
        const bool has_next = S.next(ui + 1, nxt);
        const char* nA = has_next ? (const char*)g.A + (size_t)nxt.pm * tstep : cA; const char* nB = has_next ? (const char*)g.Bt + (size_t)nxt.pn * tstep : cB;
        for (int t = 0; t < nt; t += 2) {
            const bool last = (t == nt - 2);
            const char* a1 = cA + (size_t)(t + 1) * kstep;
            const char* a2 = last ? nA : cA + (size_t)(t + 2) * kstep; const char* b2 = last ? nB : cB + (size_t)(t + 2) * kstep;
            const char* a3 = a2 + kstep; const char* b3 = b2 + kstep;
            if (last && has_next) S.a_ready(nxt);
            if constexpr (SP2) {
            PG8_LDB(B0, 0, 0); PG8_LDB(B1, 0, 1); PG8_SCHED; PG8_LDA(At, 0, 0); PG8_STAGE(PG8_SA(1, 1), a1 + hstep, voffA);
            PG8_WAIT_V(8); PG8_WAIT_L(0); PG8_BAR; PG8_MMA(0, 0, At, B0); PG8_MMA(0, 1, At, B1); PG8_BAR; PG8_SCHED;
            PG8_LDA(At, 0, 1); PG8_STAGE(PG8_SB(0, 0), b2, voffB); PG8_STAGE(PG8_SB(0, 1), b2 + hstep, voffB); PG8_STAGE(PG8_SA(0, 0), a2, voffA);
            PG8_WAIT_V(8); PG8_WAIT_L(0); PG8_BAR; PG8_MMA(1, 0, At, B0); PG8_MMA(1, 1, At, B1); PG8_BAR; PG8_SCHED;
            PG8_LDB(B0, 1, 0); PG8_LDB(B1, 1, 1); PG8_SCHED; PG8_LDA(At, 1, 0); PG8_STAGE(PG8_SA(0, 1), a2 + hstep, voffA);
            PG8_WAIT_V(8); PG8_WAIT_L(0); PG8_BAR; PG8_MMA(0, 0, At, B0); PG8_MMA(0, 1, At, B1); PG8_BAR; PG8_SCHED;
            PG8_LDA(At, 1, 1); PG8_STAGE(PG8_SB(1, 0), b3, voffB); PG8_STAGE(PG8_SB(1, 1), b3 + hstep, voffB); PG8_STAGE(PG8_SA(1, 0), a3, voffA);
            PG8_WAIT_V(8); PG8_WAIT_L(0); PG8_BAR; PG8_MMA(1, 0, At, B0); PG8_MMA(1, 1, At, B1); PG8_BAR; PG8_SCHED;
            } else {
            PG8_LDB(B0, 0, 0); PG8_SCHED; PG8_LDA(At, 0, 0); PG8_STAGE(PG8_SA(1, 1), a1 + hstep, voffA);
            PG8_WAIT_L(8); PG8_BAR; PG8_WAIT_L(0); PG8_MMA(0, 0, At, B0); PG8_BAR; PG8_SCHED;
            PG8_LDB(B1, 0, 1); PG8_STAGE(PG8_SB(0, 0), b2, voffB);
            PG8_BAR; PG8_WAIT_L(0); PG8_MMA(0, 1, At, B1); PG8_BAR;
            PG8_LDA(At, 0, 1); PG8_STAGE(PG8_SA(0, 0), a2, voffA);
            PG8_BAR; PG8_WAIT_L(0); PG8_MMA(1, 0, At, B0); PG8_BAR; PG8_SCHED;
            PG8_STAGE(PG8_SB(0, 1), b2 + hstep, voffB);
            PG8_WAIT_V(6); PG8_BAR; PG8_MMA(1, 1, At, B1); PG8_BAR;
            PG8_LDB(B0, 1, 0); PG8_SCHED; PG8_LDA(At, 1, 0); PG8_STAGE(PG8_SA(0, 1), a2 + hstep, voffA);
            PG8_WAIT_L(8); PG8_BAR; PG8_WAIT_L(0); PG8_MMA(0, 0, At, B0); PG8_BAR; PG8_SCHED;
            PG8_LDB(B1, 1, 1); PG8_STAGE(PG8_SB(1, 0), b3, voffB);
            PG8_BAR; PG8_WAIT_L(0); PG8_MMA(0, 1, At, B1); PG8_BAR;
            PG8_LDA(At, 1, 1); PG8_STAGE(PG8_SA(1, 0), a3, voffA);
            PG8_BAR; PG8_WAIT_L(0); PG8_MMA(1, 0, At, B0); PG8_BAR; PG8_SCHED;
            PG8_STAGE(PG8_SB(1, 1), b3 + hstep, voffB);
            PG8_WAIT_V(6); PG8_BAR; PG8_MMA(1, 1, At, B1); PG8_BAR;
            }
        }
        if constexpr (ALIGN_EPI) { if (wr == 0) PG8_BAR; }
        if constexpr (!Epi::AFTER_DRAIN) { E(acc, cur, wr, wc, fr, fq); S.done(cur); }
        if (!has_next) break;
#pragma unroll
        for (int a = 0; a < 2; ++a)
#pragma unroll
            for (int b = 0; b < 2; ++b)
#pragma unroll
                for (int m = 0; m < 4; ++m)
#pragma unroll
                    for (int n = 0; n < 2; ++n) acc[a][b][m][n] = (f32x4){0.f, 0.f, 0.f, 0.f};
        cur = nxt; cA = nA; cB = nB; ++ui;
        if constexpr (ALIGN_EPI) { if (wr == 1) PG8_BAR; }
    }
    PG8_WAIT_V(0);
    if constexpr (!ALIGN_EPI) { if (wr == 0) PG8_BAR; }
    PG8_BAR;
    if constexpr (Epi::AFTER_DRAIN) { E.fused(acc, cur, wr, wc, fr, fq, lds, wid, lane); S.done(cur); }
#undef PG8_SA
#undef PG8_SB
#undef PG8_STAGE
#undef PG8_LDA
#undef PG8_LDB
#undef PG8_MMA
#undef PG8_WAIT_V
#undef PG8_WAIT_L
#undef PG8_BAR
#undef PG8_SCHED
}
}

#define LAS __attribute__((address_space(3)))
typedef unsigned short bf16_t;
typedef short bf16x8 __attribute__((ext_vector_type(8)));
typedef float f32x4 __attribute__((ext_vector_type(4)));
typedef unsigned u32x4 __attribute__((ext_vector_type(4)));
constexpr int NWAVES = 8, NT = NWAVES * 64;
constexpr int M = 16384, DM = 1024, DIN = 3072, SEQ = 2048, DEPTH = 2;
constexpr size_t MiB = 1u << 20;
constexpr size_t WS_WIN = 2 * MiB, WS_WOUT = 14 * MiB, WS_PW = 18 * MiB, WS_POOL = 18 * MiB + 256 * 1024, WS_SGW = 18 * MiB + 512 * 1024;
constexpr size_t WS_SSQ = 19 * MiB, WS_XB = 20 * MiB, WS_Y = 52 * MiB, WS_VT = 84 * MiB, WS_Z = 92 * MiB, WS_END = 188 * MiB;
constexpr int LDS_BYTES = 147456, RPB_OFF = 131072, BAR_LDS_OFF = 146432;
constexpr int L_R0 = 0, L_R1 = 49920, L_R2 = 91904, L_STAT = 129024, ROWB = 528  , VNT_ROWB = 272;
#define MFMA16(a, b, c) __builtin_amdgcn_mfma_f32_16x16x32_bf16((a), (b), (c), 0, 0, 0)
#define LDS_WAIT() asm volatile("s_waitcnt lgkmcnt(0)" ::: "memory")
#define LBAR() do { asm volatile("s_waitcnt lgkmcnt(0)" ::: "memory"); __builtin_amdgcn_s_barrier(); asm volatile("" ::: "memory"); } while (0)

#ifndef G2REP
#define G2REP 1
#endif
#ifndef G1REP
#define G1REP 1
#endif
#ifndef PROREP
#define PROREP 1
#endif
#ifndef USE_CG_SYNC
#define USE_CG_SYNC 0
#endif
#ifndef NA_PROBE_VAR
#define NA_PROBE_VAR 0
#endif
#ifndef REP_NA
#define REP_NA 1
#endif
#ifndef REP_CONV
#define REP_CONV 1
#endif
#ifndef REP_POOL
#define REP_POOL 1
#endif
#ifndef REP_SGU
#define REP_SGU 1
#endif
#ifndef NA_UNROLL
#define NA_UNROLL 4
#endif
#ifndef MIXREP
#define MIXREP 1
#endif
#ifndef MIXMASK
#define MIXMASK 15
#endif
#ifndef PHMASK
#define PHMASK 31
#endif
struct Args { const float* in[17]; float* out; unsigned char* ws; int ph_lo, ph_hi; };

#define XB_TMO      128
#define XB_XCNT(j)  (256  + 64 * (j))
#define XB_XSUB(j)  (1280 + 64 * (j))
#define XB_XGEN(j)  (2304 + 64 * (j))
#define XB_TOP      3328
#define XB_TOPGEN   3392
#define XCD_BAR_WORDS 3456
#define XB_SPIN_CAP (1u << 18)

__device__ __forceinline__ unsigned xb_ld(unsigned* p)              { return __hip_atomic_load(p, __ATOMIC_RELAXED, __HIP_MEMORY_SCOPE_AGENT); }
__device__ __forceinline__ unsigned xb_add(unsigned* p, unsigned v) { return __hip_atomic_fetch_add(p, v, __ATOMIC_RELAXED, __HIP_MEMORY_SCOPE_AGENT); }
__device__ __forceinline__ unsigned xb_xcc_id() { return (unsigned)__builtin_amdgcn_s_getreg((3 << 11) | 20) & 0xFu; }
#define XB_SPIN(cond, bar) do { unsigned _sp = 0; while (cond) { __builtin_amdgcn_s_sleep(1); \
    if ((++_sp & 255u) == 0u) { if (xb_ld(&(bar)[XB_TMO])) break; if (_sp > XB_SPIN_CAP) { atomicAdd(&(bar)[XB_TMO], 1u); break; } } } } while (0)

struct XcdBarrier {
    unsigned* bar; unsigned x;
    volatile LAS unsigned* st;
};

__device__ __forceinline__ XcdBarrier xcd_barrier_post(unsigned* bar, volatile LAS unsigned* st) {
    XcdBarrier b; b.bar = bar; b.x = xb_xcc_id(); b.st = st;
    if (threadIdx.x == 0) (void)xb_add(&bar[XB_XCNT(b.x)], 1u);
    return b;
}
__device__ __forceinline__ void xcd_barrier_complete(unsigned* bar, unsigned x, unsigned& nloc, unsigned& nx) {
    const unsigned G = gridDim.x * gridDim.y * gridDim.z;
    unsigned sum, cnt, mine, sp = 0u;
    for (;;) {
        sum = 0u; cnt = 0u; mine = 0u;
#pragma unroll
        for (unsigned j = 0; j < 16; ++j) { const unsigned c = xb_ld(&bar[XB_XCNT(j)]); sum += c; cnt += (c > 0u) ? 1u : 0u; mine = (j == x) ? c : mine; }
        if (sum == G) break;
        __builtin_amdgcn_s_sleep(1);
        if ((++sp & 255u) == 0u) { if (xb_ld(&bar[XB_TMO])) break; if (sp > XB_SPIN_CAP) { atomicAdd(&bar[XB_TMO], 1u); break; } }
    }
    nloc = mine > 0u ? mine : 1u; nx = cnt > 0u ? cnt : 1u;
}

__device__ __forceinline__ void xcd_barrier(const XcdBarrier& b) {
    asm volatile("s_waitcnt vmcnt(0)" ::: "memory");
    __syncthreads();
    if (threadIdx.x == 0) {
        unsigned* bar = b.bar;
        __builtin_amdgcn_s_waitcnt(0);
        unsigned nloc = b.st[0], nx = b.st[1];
        if (nloc == 0u) { xcd_barrier_complete(bar, b.x, nloc, nx); b.st[0] = nloc; b.st[1] = nx; }
        const unsigned old = xb_add(&bar[XB_XSUB(b.x)], 1u);
        const unsigned gen = old / nloc;
        if (old + 1u == (gen + 1u) * nloc) {
            __builtin_amdgcn_fence(__ATOMIC_RELEASE, "agent");
            asm volatile("s_waitcnt vmcnt(0)" ::: "memory");
            const unsigned og = xb_add(&bar[XB_TOP], 1u);
            const unsigned tg = og / nx;
            if (og + 1u == (tg + 1u) * nx) xb_add(&bar[XB_TOPGEN], 1u);
            else XB_SPIN(xb_ld(&bar[XB_TOPGEN]) == tg, bar);
            __builtin_amdgcn_fence(__ATOMIC_ACQUIRE, "agent");
            xb_add(&bar[XB_XGEN(b.x)], 1u);
            asm volatile("s_waitcnt vmcnt(0)" ::: "memory");
        } else {
            XB_SPIN(xb_ld(&bar[XB_XGEN(b.x)]) == gen, bar);
            __builtin_amdgcn_fence(__ATOMIC_ACQUIRE, "agent");
            asm volatile("s_waitcnt vmcnt(0)" ::: "memory");
        }
    }
    __syncthreads();
}

__device__ __forceinline__ void transpose_item(const float* W, int K, int N, bf16_t* WT, LAS float* scr, int item, int lane, const float* ks, const float* ns, int qcols) {
    const int nblk = N / 32, kb = item / nblk, nb = item % nblk, k0 = 64 * kb, n0 = 32 * nb, n = n0 + (lane & 31);
    float nsv = ns ? ns[n] : 1.f; if (n < qcols) nsv *= 0.17677669529663687f;
#pragma unroll 8
    for (int i = 0; i < 32; ++i) { const int kk = 2 * i + (lane >> 5); const float kv = ks ? ks[k0 + kk] : 1.f; scr[kk * 33 + (lane & 31)] = W[(size_t)(k0 + kk) * N + n] * (kv * nsv); }
    LDS_WAIT(); asm volatile("" ::: "memory");
    const int c = lane & 7;
#pragma unroll
    for (int j = 0; j < 4; ++j) { const int nn = (lane >> 3) + 8 * j; const LAS float* s = scr + (8 * c) * 33 + nn;
        u32x4 o; o.x = pk2(s[0 * 33], s[1 * 33]); o.y = pk2(s[2 * 33], s[3 * 33]); o.z = pk2(s[4 * 33], s[5 * 33]); o.w = pk2(s[6 * 33], s[7 * 33]);
        *(u32x4*)(WT + (size_t)(n0 + nn) * K + k0 + 8 * c) = o; }
    LDS_WAIT(); asm volatile("" ::: "memory");
}
__device__ __forceinline__ void prologue(LAS unsigned char* lds, const Args& a) {
    const int tid = threadIdx.x, lane = tid & 63, wave = __builtin_amdgcn_readfirstlane(tid >> 6);
    LAS float* scr = (LAS float*)(lds + wave * 16384);
    const int gw = blockIdx.x * NWAVES + wave, NGW = gridDim.x * NWAVES;
    unsigned char* ws = a.ws;
    constexpr int I_IN = 16 * 96, I_OUT = 16 * 32, I_PW = 4 * 8, I_PL = 2, PER_L = I_IN + I_OUT + I_PW + 4 * I_PL;
    for (int it = gw; it < DEPTH * PER_L; it += NGW) {
        const int l = it / PER_L; int r = it % PER_L;
        if (r < I_IN) { transpose_item(a.in[2] + (size_t)l * DM * DIN, DM, DIN, (bf16_t*)(ws + WS_WIN) + (size_t)l * DIN * DM, scr, r, lane, a.in[1] + l * DM, nullptr, 256); continue; } r -= I_IN;
        if (r < I_OUT) { transpose_item(a.in[15] + (size_t)l * DM * DM, DM, DM, (bf16_t*)(ws + WS_WOUT) + (size_t)l * DM * DM, scr, r, lane, nullptr, nullptr, 0); continue; } r -= I_OUT;
        if (r < I_PW) { transpose_item(a.in[8] + (size_t)l * 65536, 256, 256, (bf16_t*)(ws + WS_PW) + (size_t)l * 65536, scr, r, lane, nullptr, nullptr, 0); continue; } r -= I_PW;
        { const int g = r / I_PL, i = r % I_PL;
          transpose_item(a.in[9] + (size_t)(l * 4 + g) * 4096, 64, 64, (bf16_t*)(ws + WS_POOL) + (size_t)(l * 4 + g) * 4096, scr, i, lane, nullptr, a.in[10] + l * 256 + g * 64, 0); }
    }
    { const float* src = a.in[13]; bf16_t* dst = (bf16_t*)(ws + WS_SGW);
      for (int i = (blockIdx.x * NT + tid) * 4; i < DEPTH * 65536; i += gridDim.x * NT * 4) { const f32x4 v = *(const f32x4*)(src + i); u32x2 w; w.x = pk2(v[0], v[1]); w.y = pk2(v[2], v[3]); *(u32x2*)(dst + i) = w; } }
    { const float* x = a.in[0]; bf16_t* xb = (bf16_t*)(ws + WS_XB); float* ssq = (float*)(ws + WS_SSQ);
      for (int m = gw; m < M; m += NGW) {
          const f32x4* xr = (const f32x4*)(x + (size_t)m * DM) + lane; f32x4 v[4]; float s = 0.f;
#pragma unroll
          for (int j = 0; j < 4; ++j) { v[j] = xr[64 * j]; s += (v[j][0] * v[j][0] + v[j][1] * v[j][1]) + (v[j][2] * v[j][2] + v[j][3] * v[j][3]); }
          s = wave_sum(s);
          u32x2* o = (u32x2*)(xb + (size_t)m * DM) + lane;
#pragma unroll
          for (int j = 0; j < 4; ++j) { u32x2 w; w.x = pk2(v[j][0], v[j][1]); w.y = pk2(v[j][2], v[j][3]); o[64 * j] = w; }
          if (lane < 16) ssq[(size_t)m * 16 + lane] = (lane == 0) ? s : 0.f;
      } }
}

struct MixW { const float *rpb, *dw_w, *dw_b, *cln_g, *cln_b, *sln_g, *sln_b, *sgu_b; const bf16_t *PWT, *POOLT, *SGW; };

#define LANE_VARS int tid = tid0; asm volatile("" : "+v"(tid)); const int lane = tid & 63, fr = lane & 15, fq = lane >> 4, c0 = half * 128 + 2 * lane; (void)fr; (void)fq; (void)c0;
#define CONV_LOAD(k) do { const int task_ = tid + (k) * NT, tt_ = task_ >> 5, ch_ = task_ & 31, s_ = r * 64 - 15 + tt_; \
        cav[k] = (u32x4){0u, 0u, 0u, 0u}; cbv[k] = cav[k]; \
        if (task_ < 94 * 32 && s_ >= 0 && s_ < SEQ) { cav[k] = *(const u32x4*)(Zb + (size_t)s_ * DIN + 768 + ch_ * 8); cbv[k] = *(const u32x4*)(Zb + (size_t)s_ * DIN + 1024 + ch_ * 8); } } while (0)
__device__ __forceinline__ void na_stage(const bf16_t* Z, const bf16_t* Zb, const bf16_t* VT, bf16_t* Y, LAS float* rpbL, int b, int r, int tok0, int wid, int tid0, int half, u32x4 (&cav)[6], u32x4 (&cbv)[6]) {
    const f32x4 zero4 = {0.f, 0.f, 0.f, 0.f};
    LANE_VARS
    const int h = wid, rs = min(max(r - 4, 0), 24);
    const bf16_t* VTh = VT + (size_t)(b * 8 + h) * 32 * SEQ;
    const int kperm = (fr >> 2) * 8 + (fr & 3);
#define NA_CW0(qb) ((qb) == 0 ? 0 : ((qb) == 1 ? 8 : ((qb) == 2 ? 24 : 32)))
    const int klane = kperm * DIN + fq * 8, qlane = fr * DIN + fq * 8, vlane = fr * SEQ + fq * 8, glane = fr * DIN + 4 * fq;
    const bf16_t* Kh = Zb + (size_t)rs * 64 * DIN + 256 + h * 32;
#define NA_KLOAD(dst, qb) do { _Pragma("unroll") for (int j = 0; j < 8; ++j) _Pragma("unroll") for (int t = 0; t < 2; ++t) \
        dst[j][t] = *(const bf16x8*)((Kh + (size_t)(j * 64 + NA_CW0(qb) + t * 4) * DIN) + klane); } while (0)
#define NA_QLOAD(qb) (*(const bf16x8*)((Zb + (size_t)(r * 64 + 16 * (qb)) * DIN + h * 32) + qlane))
    bf16x8 qcur = NA_QLOAD(0), qnxt = qcur;
    bf16x8 kf[8][2];
    NA_KLOAD(kf, 0);
    __builtin_amdgcn_sched_barrier(0);
#pragma unroll
    for (int qb = 0; qb < 4; ++qb) {
        const int c = 16 * qb + fr, cw0 = NA_CW0(qb), cs = min(max(c - 8, 0), 48);
        f32x4 S[8][2];
#pragma unroll
        for (int j = 0; j < 8; ++j)
#pragma unroll
            for (int t = 0; t < 2; ++t) S[j][t] = MFMA16(kf[j][t], qcur, zero4);
        __builtin_amdgcn_sched_barrier(0);
        bf16x8 vf[8][2];
#pragma unroll
        for (int j = 0; j < 8; ++j)
#pragma unroll
            for (int dt = 0; dt < 2; ++dt) vf[j][dt] = *(const bf16x8*)((VTh + (size_t)(dt * 16) * SEQ + (rs + j) * 64 + cw0) + vlane);
        u32x2 gv[2];
#pragma unroll
        for (int dt = 0; dt < 2; ++dt) gv[dt] = *(const u32x2*)((Z + (size_t)(tok0 + 16 * qb) * DIN + 2048 + h * 32 + dt * 16) + glane);
        __builtin_amdgcn_sched_barrier(0);
        float mx = -INFINITY;
#pragma unroll
        for (int j = 0; j < 8; ++j) {
            const LAS float* rp = rpbL + h * 465 + (rs + j - r + 7) * 31 + 15;
#pragma unroll
            for (int t = 0; t < 2; ++t)
#pragma unroll
                for (int e = 0; e < 4; ++e) {
                    const int kc = cw0 + fq * 8 + t * 4 + e; const bool valid = (kc >= cs) && (kc < cs + 16);
                    const int dc = min(max(kc - c, -15), 15);
                    float sv = S[j][t][e] + rp[dc]; sv = valid ? sv : -INFINITY; S[j][t][e] = sv; mx = fmaxf(mx, sv);
                }
            if (j & 1) __builtin_amdgcn_sched_barrier(0);
        }
        mx = fmaxf(mx, __shfl_xor(mx, 16)); mx = fmaxf(mx, __shfl_xor(mx, 32));
        float sum = 0.f;
#pragma unroll
        for (int j = 0; j < 8; ++j)
#pragma unroll
            for (int t = 0; t < 2; ++t)
#pragma unroll
                for (int e = 0; e < 4; ++e) { const float p = __builtin_amdgcn_exp2f((S[j][t][e] - mx) * 1.44269504f); S[j][t][e] = p; sum += p; }
        sum += __shfl_xor(sum, 16); sum += __shfl_xor(sum, 32);
        const float inv = frcp(sum);
        f32x4 O[2] = {zero4, zero4};
        bf16x8 pf[8];
#pragma unroll
        for (int j = 0; j < 8; ++j) {
            u32x4 pw; pw.x = pk2(S[j][0][0], S[j][0][1]); pw.y = pk2(S[j][0][2], S[j][0][3]); pw.z = pk2(S[j][1][0], S[j][1][1]); pw.w = pk2(S[j][1][2], S[j][1][3]);
            pf[j] = __builtin_bit_cast(bf16x8, pw);
        }
        __builtin_amdgcn_sched_barrier(0);
        if (qb < 3) { qnxt = NA_QLOAD(qb + 1); NA_KLOAD(kf, qb + 1); }
        else {
#pragma unroll
            for (int k = 0; k < 6; ++k) CONV_LOAD(k);
        }
        __builtin_amdgcn_sched_barrier(0);
#pragma unroll
        for (int j = 0; j < 8; ++j)
#pragma unroll
            for (int dt = 0; dt < 2; ++dt) O[dt] = MFMA16(vf[j][dt], pf[j], O[dt]);
#pragma unroll
        for (int dt = 0; dt < 2; ++dt) {
            const int ch = h * 32 + dt * 16 + 4 * fq;
            u32x2 w; w.x = pk2(O[dt][0] * inv * bf_lo(gv[dt].x), O[dt][1] * inv * bf_hi(gv[dt].x)); w.y = pk2(O[dt][2] * inv * bf_lo(gv[dt].y), O[dt][3] * inv * bf_hi(gv[dt].y));
            *(u32x2*)(Y + (size_t)(tok0 + c) * DM + ch) = w;
        }
        qcur = qnxt;
        __builtin_amdgcn_sched_barrier(0);
    }
}

__device__ __forceinline__ void mixer_phase(LAS unsigned char* lds, const bf16_t* Z, const bf16_t* VT, bf16_t* Y, const MixW& W) {
    const int tid0 = threadIdx.x, wid = __builtin_amdgcn_readfirstlane(tid0 >> 6);
    LAS float* rpbL = (LAS float*)(lds + RPB_OFF);
    for (int i = tid0; i < 8 * 465; i += NT) rpbL[i] = W.rpb[i];
    const f32x4 zero4 = {0.f, 0.f, 0.f, 0.f};
    const int tq = wid >> 1, half = wid & 1;
    for (int item = blockIdx.x; item < 256; item += gridDim.x) {
        LBAR();
        const int b = item & 7, r = item >> 3, tok0 = b * SEQ + r * 64;
        const bf16_t* Zb = Z + (size_t)b * SEQ * DIN;
        u32x4 cav[6], cbv[6];
        u32x4 pv[5];
        u32x2 raw[16];
        na_stage(Z, Zb, VT, Y, rpbL, b, r, tok0, wid, tid0, half, cav, cbv);
        {
            LANE_VARS
            LAS unsigned char* Hb = lds + L_R0; LAS unsigned char* Hn = lds + L_R0; LAS unsigned char* Cf = lds + L_R1; LAS f32x2* stat = (LAS f32x2*)(lds + L_STAT);
            const int cb = (r & ~1) * 64;
#pragma unroll
            for (int k = 0; k < 6; ++k) {
                const int task = tid + k * NT, tt = task >> 5, ch = task & 31;
                u32x4 o;
#pragma unroll
                for (int e = 0; e < 4; ++e) { const float a0 = bf_lo(cav[k][e]), a1 = bf_hi(cav[k][e]), b0 = bf_lo(cbv[k][e]), b1 = bf_hi(cbv[k][e]);
                    o[e] = pk2(a0 * frcp(1.f + fexp(-b0)), a1 * frcp(1.f + fexp(-b1))); }
                if (task < 94 * 32) *(LAS u32x4*)(Hb + tt * ROWB + ch * 16) = o;
            }
            __builtin_amdgcn_sched_barrier(0);
#pragma unroll
            for (int k = 0; k < 5; ++k) {
                const int task = tid + k * NT, tt = task >> 5, ch = task & 31, s = r * 64 - 8 + tt;
                pv[k] = (u32x4){0u, 0u, 0u, 0u};
                if (task < 79 * 32 && s >= 0 && s < SEQ) pv[k] = *(const u32x4*)(Zb + (size_t)s * DIN + 1280 + ch * 8);
            }
#pragma unroll
            for (int i = 0; i < 16; ++i) raw[i] = *(const u32x2*)(Zb + (size_t)(cb + wid * 16 + i) * DIN + 1792 + 4 * lane);
            f32x2 wv[31];
#pragma unroll
            for (int j = 0; j < 31; ++j) wv[j] = *(const f32x2*)(W.dw_w + j * 256 + c0);
            const f32x2 bias = *(const f32x2*)(W.dw_b + c0);
            __builtin_amdgcn_sched_barrier(0);
            LBAR();
#pragma unroll 1
            for (int p = 0; p < 2; ++p) {
                const int tb = tq * 16 + p * 8;
                float a0[8], a1[8];
#pragma unroll
                for (int t = 0; t < 8; ++t) { a0[t] = bias[0]; a1[t] = bias[1]; }
#pragma unroll
                for (int jg = 0; jg < 40; jg += 8) {
                    unsigned hv[8];
#pragma unroll
                    for (int i = 0; i < 8; ++i) if (jg + i < 38) hv[i] = *(const LAS unsigned*)(Hb + (tb + jg + i) * ROWB + c0 * 2);
#pragma unroll
                    for (int i = 0; i < 8; ++i) if (jg + i < 38) {
                        const int jj = jg + i; const float v0 = bf_lo(hv[i]), v1 = bf_hi(hv[i]);
#pragma unroll
                        for (int t = 0; t < 8; ++t) { const int tap = jj - t; if (tap >= 0 && tap <= 30) { a0[t] += v0 * wv[tap][0]; a1[t] += v1 * wv[tap][1]; } }
                    }
                    __builtin_amdgcn_sched_barrier(0);
                }
#pragma unroll
                for (int t = 0; t < 8; ++t) {
                    const float s1 = wave_sum(a0[t] + a1[t]), s2 = wave_sum(a0[t] * a0[t] + a1[t] * a1[t]);
                    if (lane == 0) stat[(tb + t) * 2 + half] = (f32x2){s1, s2};
                    *(LAS f32x2*)(Cf + ((tb + t) * 256 + c0) * 4) = (f32x2){a0[t], a1[t]};
                }
            }
            const f32x2 lg = *(const f32x2*)(W.cln_g + c0), lb = *(const f32x2*)(W.cln_b + c0);
            bf16x8 afw[8][2];
#pragma unroll
            for (int ks = 0; ks < 8; ++ks)
#pragma unroll
                for (int nt = 0; nt < 2; ++nt) afw[ks][nt] = *(const bf16x8*)(W.PWT + (size_t)(wid * 32 + nt * 16 + fr) * 256 + ks * 32 + fq * 8);
            u32x2 gvv[2][4];
#pragma unroll
            for (int nt = 0; nt < 2; ++nt)
#pragma unroll
                for (int tt = 0; tt < 4; ++tt) gvv[nt][tt] = *(const u32x2*)(Z + (size_t)(tok0 + tt * 16 + fr) * DIN + 2048 + 256 + wid * 32 + nt * 16 + 4 * fq);
            __builtin_amdgcn_sched_barrier(0);
            LBAR();
#pragma unroll 4
            for (int t = 0; t < 16; ++t) {
                const f32x2 p = stat[(tq * 16 + t) * 2], q = stat[(tq * 16 + t) * 2 + 1];
                const f32x2 cv = *(const LAS f32x2*)(Cf + ((tq * 16 + t) * 256 + c0) * 4);
                const float mean = (p[0] + q[0]) * (1.f / 256.f), var = (p[1] + q[1]) * (1.f / 256.f) - mean * mean, rstd = __builtin_amdgcn_rsqf(var + 1e-5f);
                const float y0 = (cv[0] - mean) * rstd * lg[0] + lb[0], y1 = (cv[1] - mean) * rstd * lg[1] + lb[1];
                *(LAS unsigned*)(Hn + (tq * 16 + t) * ROWB + c0 * 2) = pk2(silu_f(y0), silu_f(y1));
            }
            LBAR();
            f32x4 acc[2][4];
#pragma unroll
            for (int nt = 0; nt < 2; ++nt)
#pragma unroll
                for (int tt = 0; tt < 4; ++tt) acc[nt][tt] = zero4;
#pragma unroll
            for (int ks = 0; ks < 8; ++ks) {
                bf16x8 bfr[4];
#pragma unroll
                for (int tt = 0; tt < 4; ++tt) bfr[tt] = *(const LAS bf16x8*)(Hn + (tt * 16 + fr) * ROWB + (ks * 32 + fq * 8) * 2);
#pragma unroll
                for (int nt = 0; nt < 2; ++nt)
#pragma unroll
                    for (int tt = 0; tt < 4; ++tt) acc[nt][tt] = MFMA16(afw[ks][nt], bfr[tt], acc[nt][tt]);
            }
#pragma unroll
            for (int nt = 0; nt < 2; ++nt)
#pragma unroll
                for (int tt = 0; tt < 4; ++tt) {
                    const int ch = wid * 32 + nt * 16 + 4 * fq; const size_t tok = (size_t)(tok0 + tt * 16 + fr);
                    const u32x2 gv = gvv[nt][tt];
                    u32x2 w; w.x = pk2(acc[nt][tt][0] * bf_lo(gv.x), acc[nt][tt][1] * bf_hi(gv.x)); w.y = pk2(acc[nt][tt][2] * bf_lo(gv.y), acc[nt][tt][3] * bf_hi(gv.y));
                    *(u32x2*)(Y + tok * DM + 256 + ch) = w;
                }
        }
        {
            LANE_VARS
            LAS unsigned char* Pin = lds + L_R1; LAS unsigned char* Pn = lds + L_R2;
#pragma unroll
            for (int k = 0; k < 5; ++k) { const int task = tid + k * NT, tt = task >> 5, ch = task & 31; if (task < 79 * 32) *(LAS u32x4*)(Pin + tt * ROWB + ch * 16) = pv[k]; }
            bf16x8 afp[2][2];
#pragma unroll
            for (int ks = 0; ks < 2; ++ks)
#pragma unroll
                for (int nt = 0; nt < 2; ++nt) afp[ks][nt] = *(const bf16x8*)(W.POOLT + (size_t)(wid * 32 + nt * 16 + fr) * 64 + ks * 32 + fq * 8);
            u32x2 gvp[2][4];
#pragma unroll
            for (int nt = 0; nt < 2; ++nt)
#pragma unroll
                for (int tt = 0; tt < 4; ++tt) gvp[nt][tt] = *(const u32x2*)(Z + (size_t)(tok0 + tt * 16 + fr) * DIN + 2048 + 512 + wid * 32 + nt * 16 + 4 * fq);
            __builtin_amdgcn_sched_barrier(0);
            LBAR();
            {
                const int g = half * 2 + (lane >> 5), w = 2 << g, hw = w >> 1;
                f32x2 x[31];
#pragma unroll
                for (int i = 0; i < 31; ++i) { const unsigned v = *(const LAS unsigned*)(Pin + (tq * 16 + i) * ROWB + c0 * 2); x[i] = (f32x2){bf_lo(v), bf_hi(v)}; }
                f32x2 S2 = x[7] + x[8], S4 = (x[6] + x[9]) + S2, S8 = ((x[4] + x[5]) + (x[10] + x[11])) + S4, S16 = (((x[0] + x[1]) + (x[2] + x[3])) + ((x[12] + x[13]) + (x[14] + x[15]))) + S8;
#pragma unroll
                for (int t = 0; t < 16; ++t) {
                    const int ta = tq * 16 + t, s = r * 64 + ta;
                    const int lo = max(s - hw, 0), hi = min(s - hw + w, SEQ);
                    const f32x2 sw = (g == 0) ? S2 : ((g == 1) ? S4 : ((g == 2) ? S8 : S16));
                    const float ic = 1.f / (float)(hi - lo);
                    *(LAS unsigned*)(Pn + ta * ROWB + c0 * 2) = pk2(sw[0] * ic - x[t + 8][0], sw[1] * ic - x[t + 8][1]);
                    if (t < 15) { S2 += x[t + 9] - x[t + 7]; S4 += x[t + 10] - x[t + 6]; S8 += x[t + 12] - x[t + 4]; S16 += x[t + 16] - x[t]; }
                }
            }
            LBAR();
            f32x4 acc[2][4];
#pragma unroll
            for (int nt = 0; nt < 2; ++nt)
#pragma unroll
                for (int tt = 0; tt < 4; ++tt) acc[nt][tt] = zero4;
            const int g = wid >> 1;
#pragma unroll
            for (int ks = 0; ks < 2; ++ks) {
                bf16x8 bfr[4];
#pragma unroll
                for (int tt = 0; tt < 4; ++tt) bfr[tt] = *(const LAS bf16x8*)(Pn + (tt * 16 + fr) * ROWB + (g * 64 + ks * 32 + fq * 8) * 2);
#pragma unroll
                for (int nt = 0; nt < 2; ++nt)
#pragma unroll
                    for (int tt = 0; tt < 4; ++tt) acc[nt][tt] = MFMA16(afp[ks][nt], bfr[tt], acc[nt][tt]);
            }
#pragma unroll
            for (int nt = 0; nt < 2; ++nt)
#pragma unroll
                for (int tt = 0; tt < 4; ++tt) {
                    const int ch = wid * 32 + nt * 16 + 4 * fq; const size_t tok = (size_t)(tok0 + tt * 16 + fr);
                    const u32x2 gv = gvp[nt][tt];
                    u32x2 w; w.x = pk2(acc[nt][tt][0] * bf_lo(gv.x), acc[nt][tt][1] * bf_hi(gv.x)); w.y = pk2(acc[nt][tt][2] * bf_lo(gv.y), acc[nt][tt][3] * bf_hi(gv.y));
                    *(u32x2*)(Y + tok * DM + 512 + ch) = w;
                }
        }
        {
            LANE_VARS
            LAS unsigned char* vnT = lds;
            const int ph = r & 1;
            const f32x4 lg = *(const f32x4*)(W.sln_g + 4 * lane), lb = *(const f32x4*)(W.sln_b + 4 * lane);
            const int h = wid >> 1, dh = wid & 1;
            bf16x8 bsw[4][4];
#pragma unroll
            for (int ks = 0; ks < 4; ++ks)
#pragma unroll
                for (int pt = 0; pt < 4; ++pt) bsw[ks][pt] = *(const bf16x8*)(W.SGW + (size_t)(h * 128 + ph * 64 + pt * 16 + fr) * 128 + ks * 32 + fq * 8);
            u32x2 uvv[4][2], gvs[4][2];
#pragma unroll
            for (int pt = 0; pt < 4; ++pt)
#pragma unroll
                for (int dt = 0; dt < 2; ++dt) { const size_t o = (size_t)(tok0 + pt * 16 + fr) * DIN + h * 64 + (2 * dh + dt) * 16 + 4 * fq; uvv[pt][dt] = *(const u32x2*)(Z + o + 1536); gvs[pt][dt] = *(const u32x2*)(Z + o + 2048 + 768); }
            __builtin_amdgcn_sched_barrier(0);
#pragma unroll
            for (int i = 0; i < 16; ++i) {
                const int q = wid * 16 + i;
                const float x0 = bf_lo(raw[i].x), x1 = bf_hi(raw[i].x), x2 = bf_lo(raw[i].y), x3 = bf_hi(raw[i].y);
                const float sm = wave_sum((x0 + x1) + (x2 + x3)), sq = wave_sum((x0 * x0 + x1 * x1) + (x2 * x2 + x3 * x3));
                const float mean = sm * (1.f / 256.f), var = sq * (1.f / 256.f) - mean * mean, rstd = __builtin_amdgcn_rsqf(var + 1e-5f);
                LAS unsigned char* dst = vnT + (4 * lane) * VNT_ROWB + q * 2;
                *(LAS unsigned short*)(dst) = bf1((x0 - mean) * rstd * lg[0] + lb[0]);
                *(LAS unsigned short*)(dst + VNT_ROWB) = bf1((x1 - mean) * rstd * lg[1] + lb[1]);
                *(LAS unsigned short*)(dst + 2 * VNT_ROWB) = bf1((x2 - mean) * rstd * lg[2] + lb[2]);
                *(LAS unsigned short*)(dst + 3 * VNT_ROWB) = bf1((x3 - mean) * rstd * lg[3] + lb[3]);
            }
            LBAR();
            f32x4 acc[2][4];
#pragma unroll
            for (int dt = 0; dt < 2; ++dt)
#pragma unroll
                for (int pt = 0; pt < 4; ++pt) acc[dt][pt] = zero4;
#pragma unroll
            for (int ks = 0; ks < 4; ++ks) {
                bf16x8 af[2];
#pragma unroll
                for (int dt = 0; dt < 2; ++dt) af[dt] = *(const LAS bf16x8*)(vnT + (h * 64 + (2 * dh + dt) * 16 + fr) * VNT_ROWB + (ks * 32 + fq * 8) * 2);
#pragma unroll
                for (int dt = 0; dt < 2; ++dt)
#pragma unroll
                    for (int pt = 0; pt < 4; ++pt) acc[dt][pt] = MFMA16(af[dt], bsw[ks][pt], acc[dt][pt]);
            }
#pragma unroll
            for (int pt = 0; pt < 4; ++pt) {
                const float bsv = W.sgu_b[h * 128 + ph * 64 + pt * 16 + fr]; const size_t tok = (size_t)(tok0 + pt * 16 + fr);
#pragma unroll
                for (int dt = 0; dt < 2; ++dt) {
                    const int ch = h * 64 + (2 * dh + dt) * 16 + 4 * fq;
                    const u32x2 uv = uvv[pt][dt], gv = gvs[pt][dt];
                    u32x2 w; w.x = pk2((acc[dt][pt][0] + bsv) * bf_lo(uv.x) * bf_lo(gv.x), (acc[dt][pt][1] + bsv) * bf_hi(uv.x) * bf_hi(gv.x));
                    w.y = pk2((acc[dt][pt][2] + bsv) * bf_lo(uv.y) * bf_lo(gv.y), (acc[dt][pt][3] + bsv) * bf_hi(uv.y) * bf_hi(gv.y));
                    *(u32x2*)(Y + tok * DM + 768 + ch) = w;
                }
            }
        }
    }
}

__device__ __forceinline__ void final_phase(float* out, const float* ssq, const float* fg) {
    const int tid = threadIdx.x, lane = tid & 63, wave = tid >> 6;
    const int gw = blockIdx.x * NWAVES + wave, NGW = gridDim.x * NWAVES;
    f32x4 g[4];
#pragma unroll
    for (int j = 0; j < 4; ++j) g[j] = *((const f32x4*)fg + lane + 64 * j);
    for (int m = gw; m < M; m += NGW) {
        const f32x4* sp = (const f32x4*)(ssq + (size_t)m * 16);
        const f32x4 st = (sp[0] + sp[1]) + (sp[2] + sp[3]);
        const float rs = __builtin_amdgcn_rsqf(((st[0] + st[1]) + (st[2] + st[3])) * (1.0f / 1024.0f) + 1e-6f);
        f32x4* xr = (f32x4*)(out + (size_t)m * DM) + lane;
        f32x4 v[4];
#pragma unroll
        for (int j = 0; j < 4; ++j) v[j] = xr[64 * j];
#pragma unroll
        for (int j = 0; j < 4; ++j) xr[64 * j] = v[j] * rs * g[j];
    }
}

__global__ void __launch_bounds__(NT, 2) fwd_megakernel(Args a) {
    extern __shared__ __attribute__((aligned(16))) unsigned char lds_raw[];
    LAS unsigned char* lds = (LAS unsigned char*)lds_raw;
    cg::grid_group grid = cg::this_grid();
    volatile LAS unsigned* bst = (volatile LAS unsigned*)(lds + BAR_LDS_OFF);
    if (threadIdx.x < 2) bst[threadIdx.x] = 0u;
    __syncthreads();
    XcdBarrier bar = xcd_barrier_post((unsigned*)a.ws, bst);
    unsigned char* ws = a.ws;
    const int lo = a.ph_lo, hi = a.ph_hi;
#define IN(k) (lo <= (k) && (k) < hi)
#define SEAM(k) do { if (IN(k) && IN((k) + 1)) { if (USE_CG_SYNC && (k) == 0) grid.sync(); else xcd_barrier(bar); } } while (0)
    bf16_t* XB = (bf16_t*)(ws + WS_XB); bf16_t* Zp = (bf16_t*)(ws + WS_Z); bf16_t* VT = (bf16_t*)(ws + WS_VT); bf16_t* Yp = (bf16_t*)(ws + WS_Y); float* ssq = (float*)(ws + WS_SSQ);
    if ((PHMASK & 1) && IN(0)) { for (int rep = 0; rep < PROREP; ++rep) { prologue(lds, a); __syncthreads(); } }
    SEAM(0);
    for (int l = 0; l < DEPTH; ++l) {
        const int p0 = 1 + 3 * l;
        if ((PHMASK & 2) && IN(p0)) {
            pg8::Gemm g{XB, (const bf16_t*)(ws + WS_WIN) + (size_t)l * DIN * DM, M, DIN, DM}; pg8::StaticOrder S; S.init(M, DIN, (int)gridDim.x, (int)blockIdx.x);
            pg8::EpiZ E{Zp, VT, ssq};
            for (int rep = 0; rep < G1REP; ++rep) pg8::gemm_phase<pg8::EpiZ, pg8::StaticOrder, true, true>(lds, g, S, E);
        }
        SEAM(p0);
        if ((PHMASK & 4) && IN(p0 + 1)) {
            MixW W;
            W.rpb = a.in[3] + (size_t)l * 8 * 465; W.dw_w = a.in[4] + (size_t)l * 31 * 256; W.dw_b = a.in[5] + l * 256; W.cln_g = a.in[6] + l * 256; W.cln_b = a.in[7] + l * 256;
            W.sln_g = a.in[11] + l * 256; W.sln_b = a.in[12] + l * 256; W.sgu_b = a.in[14] + l * 512;
            W.PWT = (const bf16_t*)(ws + WS_PW) + (size_t)l * 65536; W.POOLT = (const bf16_t*)(ws + WS_POOL) + (size_t)l * 16384; W.SGW = (const bf16_t*)(ws + WS_SGW) + (size_t)l * 65536;
            for (int rep = 0; rep < MIXREP; ++rep) mixer_phase(lds, Zp, VT, Yp, W);
            __syncthreads();
        }
        SEAM(p0 + 1);
        if ((PHMASK & 8) && IN(p0 + 2)) {
            pg8::Gemm g{Yp, (const bf16_t*)(ws + WS_WOUT) + (size_t)l * DM * DM, M, DM, DM}; pg8::StaticOrder S; S.init(M, DM, (int)gridDim.x, (int)blockIdx.x);
            pg8::EpiX E{l == 0 ? a.in[0] : a.out, a.out, XB, ssq, l + 1 < DEPTH ? 1 : 0};
            for (int rep = 0; rep < (l == 0 ? G2REP : 1); ++rep) pg8::gemm_phase<pg8::EpiX, pg8::StaticOrder, true, true>(lds, g, S, E);
        }
        SEAM(p0 + 2);
    }
    if ((PHMASK & 16) && IN(7)) final_phase(a.out, ssq, a.in[16]);
#undef IN
#undef SEAM
}

extern "C" void kernel_launch(void* const* d_in, const int* in_sizes, int n_in, void* d_out, int out_size, void* d_ws, size_t ws_size, hipStream_t stream) {
    static int grid = 0;
    if (grid == 0) {
        if (n_in != 17 || in_sizes[0] != M * DM || out_size != M * DM || ws_size < WS_END) { fprintf(stderr, "kernel_launch: unexpected shapes (n_in %d, in0 %d, out %d, ws %zu)\n", n_in, n_in > 0 ? in_sizes[0] : -1, out_size, ws_size); grid = -1; return; }
        int dev = 0, cus = 0, per_cu = 0;
        if (hipGetDevice(&dev) != hipSuccess || hipDeviceGetAttribute(&cus, hipDeviceAttributeMultiprocessorCount, dev) != hipSuccess) { grid = -1; return; }
        if (hipFuncSetAttribute((const void*)fwd_megakernel, hipFuncAttributeMaxDynamicSharedMemorySize, LDS_BYTES) != hipSuccess) { fprintf(stderr, "kernel_launch: hipFuncSetAttribute failed\n"); grid = -1; return; }
        if (hipOccupancyMaxActiveBlocksPerMultiprocessor(&per_cu, (const void*)fwd_megakernel, NT, LDS_BYTES) != hipSuccess || per_cu < 1) { fprintf(stderr, "kernel_launch: occupancy query gave %d\n", per_cu); per_cu = 1; }
        (void)hipGetLastError();
        grid = cus * per_cu;
    }
    if (grid < 0) return;
    Args a{};
    for (int i = 0; i < 17; ++i) a.in[i] = (const float*)d_in[i];
    a.out = (float*)d_out; a.ws = (unsigned char*)d_ws;
    if (MK_N_LAUNCHES == 1) {
        a.ph_lo = 0; a.ph_hi = 8;
        if (hipMemsetAsync(d_ws, 0, 16384, stream) != hipSuccess) { fprintf(stderr, "kernel_launch: memset of the barrier words failed\n"); return; }
        void* args[] = {&a};
        hipError_t e = hipLaunchCooperativeKernel((const void*)fwd_megakernel, dim3(grid), dim3(NT), args, LDS_BYTES, stream);
        if (e != hipSuccess) fprintf(stderr, "cooperative launch failed: %s (grid %d)\n", hipGetErrorString(e), grid);
    } else {
        for (int p = 0; p < 8; ++p) {
            a.ph_lo = p; a.ph_hi = p + 1;
            hipLaunchKernelGGL(fwd_megakernel, dim3(grid), dim3(NT), LDS_BYTES, stream, a);
        }
    }
}
```
